# Optimizing an MI355X kernel written in HIP

```python
import math
import jax, jax.numpy as jnp
from jax import lax
import numpy as np

D_MODEL = 2048
BATCH = 2
SEQ = 4096
DEPTH = 4

N_BRANCH = 3
W_MIX = D_MODEL // 2
S5_GROUP = 16
S5_GROUPS = W_MIX // S5_GROUP
S5_STATE = 64
S5_DT_MIN = 1e-3
S5_DT_MAX = 1e-1
RG_BLOCKS = 16
RG_BLOCK = W_MIX // RG_BLOCKS
RG_CONV = 4
RG_C = 8.0
HG_HEADS = 8
HG_DK = W_MIX // HG_HEADS
HG_DV = W_MIX // HG_HEADS
HG_CHUNK = 64
EPS = 1e-6

N_IN = 8 * W_MIX + N_BRANCH * D_MODEL
SPLITS = tuple(W_MIX * k for k in range(1, 9))

kernel_name = "hybrid_s5_rglru_hgrn2_gated_merge"


def rms_norm(x, w):
    x32 = x.astype(jnp.float32)
    y = x32 * lax.rsqrt(jnp.mean(x32 * x32, axis=-1, keepdims=True) + EPS)
    return (y * w.astype(jnp.float32)).astype(x.dtype)


def s5_mixer(u, lam_re, lam_im, log_step, b_re, b_im, c_re, c_im, d, w_glu, b_glu):
    f32 = jnp.float32
    bsz, s, _ = u.shape
    u32 = u.astype(f32).reshape(bsz, s, S5_GROUPS, S5_GROUP)
    lam_re = lam_re.astype(f32)
    lam_im = lam_im.astype(f32)
    step = jnp.exp(log_step.astype(f32))[:, None]
    mag = jnp.exp(lam_re * step)
    ang = lam_im * step
    abar_re = mag * jnp.cos(ang)
    abar_im = mag * jnp.sin(ang)
    num_re = abar_re - 1.0
    num_im = abar_im
    den = lam_re * lam_re + lam_im * lam_im
    coef_re = (num_re * lam_re + num_im * lam_im) / den
    coef_im = (num_im * lam_re - num_re * lam_im) / den
    b_re = b_re.astype(f32)
    b_im = b_im.astype(f32)
    bbar_re = coef_re[..., None] * b_re - coef_im[..., None] * b_im
    bbar_im = coef_re[..., None] * b_im + coef_im[..., None] * b_re
    bu_re = jnp.einsum('bsgh,gph->bsgp', u32, bbar_re)
    bu_im = jnp.einsum('bsgh,gph->bsgp', u32, bbar_im)
    a_re = jnp.broadcast_to(abar_re, (1, s) + abar_re.shape)
    a_im = jnp.broadcast_to(abar_im, (1, s) + abar_im.shape)

    def combine(left, right):
        ar1, ai1, br1, bi1 = left
        ar2, ai2, br2, bi2 = right
        return (ar2 * ar1 - ai2 * ai1,
                ar2 * ai1 + ai2 * ar1,
                ar2 * br1 - ai2 * bi1 + br2,
                ar2 * bi1 + ai2 * br1 + bi2)

    _, _, x_re, x_im = lax.associative_scan(combine, (a_re, a_im, bu_re, bu_im), axis=1)
    y = (jnp.einsum('bsgp,ghp->bsgh', x_re, c_re.astype(f32))
         - jnp.einsum('bsgp,ghp->bsgh', x_im, c_im.astype(f32)))
    y = y.reshape(bsz, s, W_MIX) + d.astype(f32) * u32.reshape(bsz, s, W_MIX)
    y = jax.nn.gelu(y)
    y = y * jax.nn.sigmoid(y @ w_glu.astype(f32) + b_glu.astype(f32))
    return y.astype(u.dtype)


def rg_lru_mixer(x, conv_w, conv_b, w_a, b_a, w_x, b_x, lam):
    f32 = jnp.float32
    bsz, s, _ = x.shape
    x32 = x.astype(f32)
    xc = lax.conv_general_dilated(
        x32, conv_w.astype(f32).reshape(RG_CONV, 1, W_MIX),
        window_strides=(1,), padding=[(RG_CONV - 1, 0)],
        dimension_numbers=('NWC', 'WIO', 'NWC'),
        feature_group_count=W_MIX) + conv_b.astype(f32)
    xb = xc.reshape(bsz, s, RG_BLOCKS, RG_BLOCK)
    r = jax.nn.sigmoid(jnp.einsum('bsni,nij->bsnj', xb, w_a.astype(f32)).reshape(bsz, s, W_MIX)
                       + b_a.astype(f32))
    i = jax.nn.sigmoid(jnp.einsum('bsni,nij->bsnj', xb, w_x.astype(f32)).reshape(bsz, s, W_MIX)
                       + b_x.astype(f32))
    log_a = -RG_C * r * jax.nn.softplus(-lam.astype(f32))
    a = jnp.exp(log_a)
    mult = jnp.sqrt(-jnp.expm1(2.0 * log_a))
    is_first = (jnp.arange(s) == 0)[None, :, None]
    mult = jnp.where(is_first, jnp.ones_like(mult), mult)
    b_term = mult * (i * xc)

    def combine(left, right):
        a1, b1 = left
        a2, b2 = right
        return a2 * a1, a2 * b1 + b2

    _, h = lax.associative_scan(combine, (a, b_term), axis=1)
    return h.astype(x.dtype)


def hgrn2_mixer(q, f_logit, inp, lb, norm_w):
    f32 = jnp.float32
    bsz, s, _ = q.shape
    n_chunks = s // HG_CHUNK
    q32 = jax.nn.silu(q.astype(f32))
    f = lb + (1.0 - lb) * jax.nn.sigmoid(f_logit.astype(f32))
    k32 = 1.0 - f
    g32 = jnp.log(f)
    v32 = inp.astype(f32)

    def to_chunks(t, d):
        return t.reshape(bsz, n_chunks, HG_CHUNK, HG_HEADS, d).transpose(1, 0, 3, 2, 4)

    qc = to_chunks(q32, HG_DK)
    kc = to_chunks(k32, HG_DK)
    gc = to_chunks(g32, HG_DK)
    vc = to_chunks(v32, HG_DV)
    causal = jnp.tril(jnp.ones((HG_CHUNK, HG_CHUNK), dtype=bool))

    def chunk_step(state, xs):
        qx, kx, gx, vx = xs
        G = jnp.cumsum(gx, axis=2)
        inter = jnp.einsum('bhtk,bhkv->bhtv', qx * jnp.exp(G), state)
        diff = G[:, :, :, None, :] - G[:, :, None, :, :]
        decay = jnp.exp(jnp.where(causal[None, None, :, :, None], diff, -jnp.inf))
        attn = jnp.einsum('bhtk,bhsk,bhtsk->bhts', qx, kx, decay)
        intra = jnp.einsum('bhts,bhsv->bhtv', attn, vx)
        g_last = G[:, :, -1]
        k_dec = kx * jnp.exp(g_last[:, :, None, :] - G)
        new_state = (jnp.exp(g_last)[..., None] * state
                     + jnp.einsum('bhsk,bhsv->bhkv', k_dec, vx))
        return new_state, inter + intra

    state0 = jnp.zeros((bsz, HG_HEADS, HG_DK, HG_DV), f32)
    _, o = lax.scan(chunk_step, state0, (qc, kc, gc, vc))
    o = o.transpose(1, 0, 3, 2, 4).reshape(bsz, s, HG_HEADS, HG_DV)
    o = o * lax.rsqrt(jnp.mean(o * o, axis=-1, keepdims=True) + EPS)
    o = o * norm_w.astype(f32).reshape(HG_HEADS, HG_DV)
    return o.reshape(bsz, s, W_MIX).astype(q.dtype)


def setup_inputs(seed: int = 0) -> dict:
    key = jax.random.key(seed)
    ks = jax.random.split(key, 26)
    f32 = jnp.float32
    nrm = lambda k, shape, sc: sc * jax.random.normal(k, shape, f32)
    x = jax.random.normal(ks[0], (BATCH, SEQ, D_MODEL), f32)
    norm_w = 1.0 + nrm(ks[1], (DEPTH, D_MODEL), 0.02)
    w_in = nrm(ks[2], (DEPTH, D_MODEL, N_IN), D_MODEL ** -0.5)
    s5_lambda_re = -0.5 + nrm(ks[3], (DEPTH, S5_GROUPS, S5_STATE), 0.01)
    s5_lambda_im = (math.pi * jnp.arange(S5_STATE, dtype=f32)[None, None, :]
                    + nrm(ks[4], (DEPTH, S5_GROUPS, S5_STATE), 0.01))
    s5_log_step = jax.random.uniform(ks[5], (DEPTH, S5_GROUPS), f32,
                                     math.log(S5_DT_MIN), math.log(S5_DT_MAX))
    s5_b_re = nrm(ks[6], (DEPTH, S5_GROUPS, S5_STATE, S5_GROUP), (2 * S5_GROUP) ** -0.5)
    s5_b_im = nrm(ks[7], (DEPTH, S5_GROUPS, S5_STATE, S5_GROUP), (2 * S5_GROUP) ** -0.5)
    s5_c_re = nrm(ks[8], (DEPTH, S5_GROUPS, S5_GROUP, S5_STATE), (2 * S5_STATE) ** -0.5)
    s5_c_im = nrm(ks[9], (DEPTH, S5_GROUPS, S5_GROUP, S5_STATE), (2 * S5_STATE) ** -0.5)
    s5_d = nrm(ks[10], (DEPTH, W_MIX), 1.0)
    s5_w_glu = nrm(ks[11], (DEPTH, W_MIX, W_MIX), W_MIX ** -0.5)
    s5_b_glu = nrm(ks[12], (DEPTH, W_MIX), 0.01)
    rg_conv_w = nrm(ks[13], (DEPTH, RG_CONV, W_MIX), RG_CONV ** -0.5)
    rg_conv_b = nrm(ks[14], (DEPTH, W_MIX), 0.01)
    rg_w_a = nrm(ks[15], (DEPTH, RG_BLOCKS, RG_BLOCK, RG_BLOCK), RG_BLOCK ** -0.5)
    rg_b_a = nrm(ks[16], (DEPTH, W_MIX), 0.01)
    rg_w_x = nrm(ks[17], (DEPTH, RG_BLOCKS, RG_BLOCK, RG_BLOCK), RG_BLOCK ** -0.5)
    rg_b_x = nrm(ks[18], (DEPTH, W_MIX), 0.01)
    a0 = jax.random.uniform(ks[19], (DEPTH, W_MIX), f32, 0.9, 0.999)
    p = a0 ** (1.0 / RG_C)
    rg_lambda = jnp.log(p) - jnp.log1p(-p)
    hg_lower_bounds = nrm(ks[20], (DEPTH, W_MIX), 0.1)
    hg_norm_w = 1.0 + nrm(ks[21], (DEPTH, W_MIX), 0.02)
    w_branch = nrm(ks[22], (DEPTH, N_BRANCH, W_MIX, D_MODEL), W_MIX ** -0.5)
    w_out = nrm(ks[23], (DEPTH, D_MODEL, D_MODEL), D_MODEL ** -0.5)
    final_norm_w = 1.0 + nrm(ks[24], (D_MODEL,), 0.02)
    return {"x": x, "norm_w": norm_w, "w_in": w_in,
            "s5_lambda_re": s5_lambda_re, "s5_lambda_im": s5_lambda_im,
            "s5_log_step": s5_log_step, "s5_b_re": s5_b_re, "s5_b_im": s5_b_im,
            "s5_c_re": s5_c_re, "s5_c_im": s5_c_im, "s5_d": s5_d,
            "s5_w_glu": s5_w_glu, "s5_b_glu": s5_b_glu,
            "rg_conv_w": rg_conv_w, "rg_conv_b": rg_conv_b,
            "rg_w_a": rg_w_a, "rg_b_a": rg_b_a, "rg_w_x": rg_w_x, "rg_b_x": rg_b_x,
            "rg_lambda": rg_lambda,
            "hg_lower_bounds": hg_lower_bounds, "hg_norm_w": hg_norm_w,
            "w_branch": w_branch, "w_out": w_out, "final_norm_w": final_norm_w}


def reference(x, norm_w, w_in, s5_lambda_re, s5_lambda_im, s5_log_step, s5_b_re, s5_b_im,
              s5_c_re, s5_c_im, s5_d, s5_w_glu, s5_b_glu, rg_conv_w, rg_conv_b,
              rg_w_a, rg_b_a, rg_w_x, rg_b_x, rg_lambda, hg_lower_bounds, hg_norm_w,
              w_branch, w_out, final_norm_w):
    bsz, s, _ = x.shape
    lb_sm = jax.nn.softmax(hg_lower_bounds.astype(jnp.float32), axis=0)
    lbs = jnp.cumsum(lb_sm, axis=0) - lb_sm[0]
    for l in range(DEPTH):
        h = rms_norm(x, norm_w[l])
        z = h @ w_in[l]
        u_a, g_a, x_b, g_b, q_c, f_c, i_c, g_c, gate_logits = jnp.split(z, SPLITS, axis=-1)
        y_a = s5_mixer(u_a, s5_lambda_re[l], s5_lambda_im[l], s5_log_step[l],
                       s5_b_re[l], s5_b_im[l], s5_c_re[l], s5_c_im[l], s5_d[l],
                       s5_w_glu[l], s5_b_glu[l]) * jax.nn.silu(g_a)
        y_b = rg_lru_mixer(x_b, rg_conv_w[l], rg_conv_b[l], rg_w_a[l], rg_b_a[l],
                           rg_w_x[l], rg_b_x[l], rg_lambda[l]) * jax.nn.silu(g_b)
        y_c = hgrn2_mixer(q_c, f_c, i_c, lbs[l], hg_norm_w[l]) * jax.nn.silu(g_c)
        ys = jnp.stack([y_a, y_b, y_c], axis=2)
        branch = jnp.einsum('bsnw,nwd->bsnd', ys, w_branch[l])
        gates = jax.nn.sigmoid(gate_logits.reshape(bsz, s, N_BRANCH, D_MODEL))
        merged = jnp.sum(gates * branch, axis=2)
        x = x + merged @ w_out[l]
    return rms_norm(x, final_norm_w)
```

```cpp
#include <hip/hip_runtime.h>
#include <hip/hip_cooperative_groups.h>
#include <cstdio>
#include <cstdint>
namespace cg = cooperative_groups;
#define GSYNC() xcd_barrier(xb)

#define LAS __attribute__((address_space(3)))
typedef unsigned short bf16_t;
typedef short bf16x8 __attribute__((ext_vector_type(8)));
typedef float f32x4 __attribute__((ext_vector_type(4)));
typedef float f32x16 __attribute__((ext_vector_type(16)));
typedef unsigned u32x4 __attribute__((ext_vector_type(4)));
typedef unsigned u32x2 __attribute__((ext_vector_type(2)));
typedef unsigned long long u64;
typedef float f32x2 __attribute__((ext_vector_type(2)));
__device__ __forceinline__ float ssq_rstd(const u64* p) { return rsqrtf((float)(*p) * (1.0f / (16777216.0f * 2048.0f)) + 1e-6f); }

constexpr int T_TOK = 8192, SEQ = 4096, DM = 2048, WM = 1024, NIN = 14336, DEPTH = 4;
constexpr int ZW = 15360;
constexpr float EPS = 1e-6f;
constexpr int LDS_BYTES = 163840;

constexpr size_t OFF_SSQ = 0;
constexpr size_t OFF_LBS = 327680;
constexpr size_t OFF_S5A = 344064;
constexpr size_t OFF_S5BT = 475136;
constexpr size_t OFF_S5CT = 1523712;
constexpr size_t OFF_RGW = 2572288;
constexpr size_t OFF_BAR = 3670016;
constexpr size_t OFF_WIN = 4194304;
constexpr size_t OFF_WGLU = OFF_WIN + 234881024ull;
constexpr size_t OFF_WBR = OFF_WGLU + 8388608ull;
constexpr size_t OFF_WOUT = OFF_WBR + 50331648ull;
constexpr size_t OFF_X = OFF_WOUT + 33554432ull;
constexpr size_t OFF_XB = OFF_X + 67108864ull;
constexpr size_t OFF_Z = OFF_XB + 33554432ull;
constexpr size_t OFF_YPRE = OFF_Z + 251658240ull;
constexpr size_t OFF_Y3 = OFF_YPRE + 16777216ull;
constexpr size_t OFF_MRG = OFF_Y3 + 50331648ull;
constexpr size_t OFF_RGS = OFF_MRG + 33554432ull;
constexpr size_t OFF_OL = OFF_RGS + 524288ull;
constexpr size_t OFF_QH = OFF_OL + 33554432ull;
constexpr size_t OFF_USEG = OFF_QH + 16777216ull;
constexpr size_t OFF_DSEG = OFF_USEG + 8388608ull;
constexpr size_t WS_END = OFF_DSEG + 65536ull;
constexpr size_t OFF_FLG = OFF_BAR + 16384;

__device__ __forceinline__ unsigned pk2(float lo, float hi) { unsigned r; asm("v_cvt_pk_bf16_f32 %0, %1, %2" : "=v"(r) : "v"(lo), "v"(hi)); return r; }
__device__ __forceinline__ unsigned pk2t(float lo, float hi) { unsigned r; asm("s_nop 1\n\tv_cvt_pk_bf16_f32 %0, %1, %2" : "=v"(r) : "v"(lo), "v"(hi)); return r; }
__device__ __forceinline__ bf16_t f2bf(float f) { return (bf16_t)(pk2(f, 0.f) & 0xffffu); }
__device__ __forceinline__ float bf2f(bf16_t b) { return __uint_as_float(((unsigned)b) << 16); }
__device__ __forceinline__ float bflo(unsigned w) { return __uint_as_float(w << 16); }
__device__ __forceinline__ float bfhi(unsigned w) { return __uint_as_float(w & 0xffff0000u); }
__device__ __forceinline__ float sigmoidf_(float v) { return __builtin_amdgcn_rcpf(1.0f + __expf(-v)); }
#define LDS_WAIT() asm volatile("s_waitcnt lgkmcnt(0)" ::: "memory")
__device__ __forceinline__ int opaque_tid() { int t = threadIdx.x; asm volatile("" : "+v"(t)); return t; }

namespace pg8 {
constexpr int BM = 256, BK = 64, HALF = 128, HTB = HALF * BK * 2, STAGE_BYTES = 8 * HTB, NXCD = 8, WGM = 8;
__host__ __device__ __forceinline__ int lds_byte(int r, int c) { const int st = (r >> 4) * 2 + (c >> 5), rr = r & 15, cc = c & 31, ob = rr * 64 + cc * 2; return st * 1024 + (ob ^ (((ob >> 9) & 1) << 5)); }
__host__ __device__ __forceinline__ void stage_rc(int b, int& R, int& C) { const int st = b / 1024, sb = b % 1024, swz = sb ^ (((sb >> 9) & 1) << 5); R = (st >> 1) * 16 + swz / 64; C = (st & 1) * 32 + (swz % 64) / 2; }
__host__ __device__ __forceinline__ int perm32(int rho) { const int n = rho >> 4, i = rho & 15; return 8 * (i >> 2) + 4 * n + (i & 3); }

struct Unit { int pm, pn, br; };
struct Gemm { const bf16_t* A; const bf16_t* Bt; int M, N, K; size_t sA, sB; };

struct StaticOrder {
    int nM, nN, nwg, G, c;
    __device__ void init(int M, int N, int G_, int c_) { nM = M / BM; nN = N / BM; nwg = nM * nN; G = G_; c = c_; }
    __device__ __forceinline__ bool next(int i, Unit& u) const {
        const long L = (long)i * G + c; if (L >= nwg) return false;
        int wgid = (int)L; { const int q = nwg / NXCD, r = nwg % NXCD, xcd = wgid % NXCD, off = wgid / NXCD; wgid = (xcd < r ? xcd * (q + 1) : r * (q + 1) + (xcd - r) * q) + off; }
        const int nig = WGM * nN, gid = wgid / nig, fm = gid * WGM, gsz = (nM - fm) < WGM ? (nM - fm) : WGM;
        u.pm = fm + ((wgid % nig) % gsz); u.pn = (wgid % nig) / gsz; u.br = 0; return true;
    }
};
struct Order3 : StaticOrder {
    __device__ __forceinline__ bool next(int i, Unit& u) const { if (!StaticOrder::next(i / 3, u)) return false; u.br = i % 3; return true; }
};

template <class Epi, class Sched>
__device__ __forceinline__ void gemm_phase(LAS unsigned char* lds, const Gemm g, const Sched& S, const Epi& E) {
    const int tid = opaque_tid(), wid = __builtin_amdgcn_readfirstlane(tid >> 6), lane = tid & 63, wr = wid >> 2, wc = wid & 3, fr = lane & 15, fq = lane >> 4;
    const int K = g.K, nt = K / BK;
    unsigned voffA[2], voffB[2];
#pragma unroll
    for (int i = 0; i < 2; ++i) { int R, C; stage_rc(tid * 16 + i * 8192, R, C); const int Rb = (R & ~31) + perm32(R & 31);
        voffA[i] = (unsigned)(R * K + C) * 2u; voffB[i] = (unsigned)(Rb * K + C) * 2u; }
    const size_t kstep = (size_t)(BK * 2);
    const size_t hstep = (size_t)HALF * K * 2;
    const size_t tstep = 2 * hstep;
    const unsigned ldsw = (unsigned)wid * 1024u;
    const int aoff = lds_byte(wr * 64 + fr, fq * 8), boff = lds_byte(wc * 32 + fr, fq * 8);
#define PG8_SA(b, h) (((b) * 2 + (h)) * HTB)
#define PG8_SB(b, h) ((4 + (b) * 2 + (h)) * HTB)
#define PG8_STAGE(bufoff, gbase, voff) do { _Pragma("unroll") for (int _i = 0; _i < 2; ++_i) \
        __builtin_amdgcn_global_load_lds((const unsigned*)((const char*)(gbase) + (voff)[_i]), (LAS unsigned*)(lds + (bufoff) + ldsw + _i * 8192), 16, 0, 0); } while (0)
#define PG8_LDA(dst, b, h) do { _Pragma("unroll") for (int m = 0; m < 4; ++m) _Pragma("unroll") for (int k = 0; k < 2; ++k) dst[m][k] = *(const LAS bf16x8*)(lds + PG8_SA(b, h) + aoff + m * 2048 + k * 1024); } while (0)
#define PG8_LDB(dst, b, h) do { _Pragma("unroll") for (int n = 0; n < 2; ++n) _Pragma("unroll") for (int k = 0; k < 2; ++k) dst[n][k] = *(const LAS bf16x8*)(lds + PG8_SB(b, h) + boff + n * 2048 + k * 1024); } while (0)
#define PG8_MMA(ai, bj, At, Bt) do { __builtin_amdgcn_s_setprio(1); _Pragma("unroll") for (int m = 0; m < 4; ++m) _Pragma("unroll") for (int n = 0; n < 2; ++n) _Pragma("unroll") for (int k = 0; k < 2; ++k) \
        acc[ai][bj][m][n] = __builtin_amdgcn_mfma_f32_16x16x32_bf16(Bt[n][k], At[m][k], acc[ai][bj][m][n], 0, 0, 0); __builtin_amdgcn_s_setprio(0); } while (0)
#define PG8_WAIT_V(n) asm volatile("s_waitcnt vmcnt(" #n ")" ::: "memory")
#define PG8_WAIT_L(n) asm volatile("s_waitcnt lgkmcnt(" #n ")" ::: "memory")
#define PG8_BAR __builtin_amdgcn_s_barrier()
#define PG8_SCHED __builtin_amdgcn_sched_barrier(0)
    Unit cur, nxt; int ui = 0;
    if (!S.next(0, cur)) return;
    f32x4 acc[2][2][4][2];
#pragma unroll
    for (int a = 0; a < 2; ++a)
#pragma unroll
        for (int b = 0; b < 2; ++b)
#pragma unroll
            for (int m = 0; m < 4; ++m)
#pragma unroll
                for (int n = 0; n < 2; ++n) acc[a][b][m][n] = (f32x4){0.f, 0.f, 0.f, 0.f};
    bf16x8 At[4][2], B0[2][2], B1[2][2];
    const char* cA = (const char*)g.A + (size_t)cur.br * g.sA + (size_t)cur.pm * tstep; const char* cB = (const char*)g.Bt + (size_t)cur.br * g.sB + (size_t)cur.pn * tstep;
    PG8_STAGE(PG8_SB(0, 0), cB, voffB); PG8_STAGE(PG8_SB(0, 1), cB + hstep, voffB); PG8_STAGE(PG8_SA(0, 0), cA, voffA); PG8_STAGE(PG8_SA(0, 1), cA + hstep, voffA);
    if (wr == 1) PG8_BAR;
    PG8_WAIT_V(2); PG8_BAR;
    PG8_STAGE(PG8_SB(1, 0), cB + kstep, voffB); PG8_STAGE(PG8_SA(1, 0), cA + kstep, voffA); PG8_STAGE(PG8_SB(1, 1), cB + hstep + kstep, voffB);
    PG8_WAIT_V(6); PG8_BAR;
    for (;;) {
        const bool has_next = S.next(ui + 1, nxt);
        const char* nA = has_next ? (const char*)g.A + (size_t)nxt.br * g.sA + (size_t)nxt.pm * tstep : cA; const char* nB = has_next ? (const char*)g.Bt + (size_t)nxt.br * g.sB + (size_t)nxt.pn * tstep : cB;
        for (int t = 0; t < nt; t += 2) {
            const bool last = (t == nt - 2);
            const char* a1 = cA + (size_t)(t + 1) * kstep;
            const char* a2 = last ? nA : cA + (size_t)(t + 2) * kstep; const char* b2 = last ? nB : cB + (size_t)(t + 2) * kstep;
            const char* a3 = a2 + kstep; const char* b3 = b2 + kstep;
            PG8_LDB(B0, 0, 0); PG8_LDB(B1, 0, 1); PG8_SCHED; PG8_LDA(At, 0, 0); PG8_STAGE(PG8_SA(1, 1), a1 + hstep, voffA);
            PG8_WAIT_V(8); PG8_WAIT_L(0); PG8_BAR; PG8_MMA(0, 0, At, B0); PG8_MMA(0, 1, At, B1); PG8_BAR; PG8_SCHED;
            PG8_LDA(At, 0, 1); PG8_STAGE(PG8_SB(0, 0), b2, voffB); PG8_STAGE(PG8_SB(0, 1), b2 + hstep, voffB); PG8_STAGE(PG8_SA(0, 0), a2, voffA);
            PG8_WAIT_V(8); PG8_WAIT_L(0); PG8_BAR; PG8_MMA(1, 0, At, B0); PG8_MMA(1, 1, At, B1); PG8_BAR; PG8_SCHED;
            PG8_LDB(B0, 1, 0); PG8_LDB(B1, 1, 1); PG8_SCHED; PG8_LDA(At, 1, 0); PG8_STAGE(PG8_SA(0, 1), a2 + hstep, voffA);
            PG8_WAIT_V(8); PG8_WAIT_L(0); PG8_BAR; PG8_MMA(0, 0, At, B0); PG8_MMA(0, 1, At, B1); PG8_BAR; PG8_SCHED;
            PG8_LDA(At, 1, 1); PG8_STAGE(PG8_SB(1, 0), b3, voffB); PG8_STAGE(PG8_SB(1, 1), b3 + hstep, voffB); PG8_STAGE(PG8_SA(1, 0), a3, voffA);
            PG8_WAIT_V(8); PG8_WAIT_L(0); PG8_BAR; PG8_MMA(1, 0, At, B0); PG8_MMA(1, 1, At, B1); PG8_BAR; PG8_SCHED;
        }
        if (wr == 0) PG8_BAR;
        const bool reset = E(acc, cur, wr, wc, fr, fq);
        if (!has_next) break;
        if (reset) {
#pragma unroll
            for (int a = 0; a < 2; ++a)
#pragma unroll
                for (int b = 0; b < 2; ++b)
#pragma unroll
                    for (int m = 0; m < 4; ++m)
#pragma unroll
                        for (int n = 0; n < 2; ++n) acc[a][b][m][n] = (f32x4){0.f, 0.f, 0.f, 0.f};
        }
        cur = nxt; cA = nA; cB = nB; ++ui;
        if (wr == 1) PG8_BAR;
    }
    PG8_WAIT_V(0);
    PG8_BAR;
#undef PG8_SA
#undef PG8_SB
#undef PG8_STAGE
#undef PG8_LDA
#undef PG8_LDB
#undef PG8_MMA
#undef PG8_WAIT_V
#undef PG8_WAIT_L
#undef PG8_BAR
#undef PG8_SCHED
}
}
using pg8::Unit;

struct EpiZ {
    bf16_t* Z; const u64* ssq; const float* lbs;
    __device__ __forceinline__ bool operator()(f32x4 (&acc)[2][2][4][2], const Unit& u, int wr, int wc, int fr, int fq) const {
        const int seg = u.pn < 32 ? (u.pn >> 2) : 8;
        const int mode = (seg == 8) ? 2 : (seg == 5 ? 3 : ((seg == 1 || seg == 3 || seg == 4 || seg == 7) ? 1 : 0));
        const int zadd = seg >= 6 ? 1024 : 0;
        float rs[2][4];
#pragma unroll
        for (int ai = 0; ai < 2; ++ai)
#pragma unroll
            for (int m = 0; m < 4; ++m) rs[ai][m] = ssq_rstd(ssq + u.pm * 256 + ai * 128 + wr * 64 + m * 16 + fr);
        f32x4 lbv[2][2];
#pragma unroll
        for (int bj = 0; bj < 2; ++bj) {
            const int cl = (mode == 3) ? (u.pn * 256 + bj * 128 + wc * 32 + 8 * fq - 5120) : 0;
            lbv[bj][0] = *(const f32x4*)(lbs + cl); lbv[bj][1] = *(const f32x4*)(lbs + cl + 4);
        }
#pragma unroll
        for (int ai = 0; ai < 2; ++ai)
#pragma unroll
            for (int m = 0; m < 4; ++m) {
                const int row = u.pm * 256 + ai * 128 + wr * 64 + m * 16 + fr;
#pragma unroll
                for (int bj = 0; bj < 2; ++bj) {
                    const int c = u.pn * 256 + bj * 128 + wc * 32 + 8 * fq;
                    float v[8];
#pragma unroll
                    for (int j = 0; j < 4; ++j) { v[j] = acc[ai][bj][m][0][j] * rs[ai][m]; v[4 + j] = acc[ai][bj][m][1][j] * rs[ai][m]; }
                    bf16_t* zp = Z + (size_t)row * ZW + c + zadd;
                    if (mode == 3) {
                        float gl[8], kk[8];
#pragma unroll
                        for (int j = 0; j < 8; ++j) {
                            const float lb = j < 4 ? lbv[bj][0][j] : lbv[bj][1][j - 4];
                            const float e = __expf(-v[j]); const float sg = __builtin_amdgcn_rcpf(1.0f + e);
                            const float f = lb + (1.0f - lb) * sg;
                            gl[j] = __logf(f); kk[j] = (1.0f - lb) * (e * sg);
                        }
                        u32x4 w0, w1;
                        w0.x = pk2(gl[0], gl[1]); w0.y = pk2(gl[2], gl[3]); w0.z = pk2(gl[4], gl[5]); w0.w = pk2(gl[6], gl[7]);
                        w1.x = pk2(kk[0], kk[1]); w1.y = pk2(kk[2], kk[3]); w1.z = pk2(kk[4], kk[5]); w1.w = pk2(kk[6], kk[7]);
                        *(u32x4*)zp = w0; *(u32x4*)(zp + 1024) = w1;
                    } else {
                        float o[8];
                        if (mode == 0) {
#pragma unroll
                            for (int j = 0; j < 8; ++j) o[j] = v[j];
                        } else if (mode == 1) {
#pragma unroll
                            for (int j = 0; j < 8; ++j) o[j] = v[j] * __builtin_amdgcn_rcpf(1.0f + __expf(-v[j]));
                        } else {
#pragma unroll
                            for (int j = 0; j < 8; ++j) o[j] = __builtin_amdgcn_rcpf(1.0f + __expf(-v[j]));
                        }
                        u32x4 w0; w0.x = pk2t(o[0], o[1]); w0.y = pk2t(o[2], o[3]); w0.z = pk2t(o[4], o[5]); w0.w = pk2t(o[6], o[7]);
                        *(u32x4*)zp = w0;
                    }
                }
            }
        return true;
    }
};
struct EpiGlu {
    const bf16_t* Ypre; const bf16_t* Z; const float* bglu; bf16_t* Ya;
    __device__ __forceinline__ bool operator()(f32x4 (&acc)[2][2][4][2], const Unit& u, int wr, int wc, int fr, int fq) const {
        f32x4 bv[2][2];
#pragma unroll
        for (int bj = 0; bj < 2; ++bj) { const int c = u.pn * 256 + bj * 128 + wc * 32 + 8 * fq; bv[bj][0] = *(const f32x4*)(bglu + c); bv[bj][1] = *(const f32x4*)(bglu + c + 4); }
#pragma unroll
        for (int ai = 0; ai < 2; ++ai) {
            u32x4 yp[4][2], sg[4][2];
#pragma unroll
            for (int m = 0; m < 4; ++m)
#pragma unroll
                for (int bj = 0; bj < 2; ++bj) {
                    const int row = u.pm * 256 + ai * 128 + wr * 64 + m * 16 + fr, c = u.pn * 256 + bj * 128 + wc * 32 + 8 * fq;
                    yp[m][bj] = *(const u32x4*)(Ypre + (size_t)row * WM + c); sg[m][bj] = *(const u32x4*)(Z + (size_t)row * ZW + 1024 + c);
                }
            __builtin_amdgcn_sched_barrier(0);
#pragma unroll
            for (int m = 0; m < 4; ++m)
#pragma unroll
                for (int bj = 0; bj < 2; ++bj) {
                    const int row = u.pm * 256 + ai * 128 + wr * 64 + m * 16 + fr, c = u.pn * 256 + bj * 128 + wc * 32 + 8 * fq;
                    float o[8];
#pragma unroll
                    for (int j = 0; j < 8; ++j) {
                        const float a = (j < 4 ? acc[ai][bj][m][0][j] : acc[ai][bj][m][1][j - 4]) + (j < 4 ? bv[bj][0][j] : bv[bj][1][j - 4]);
                        const unsigned ypw = yp[m][bj][j >> 1], sgw = sg[m][bj][j >> 1];
                        const float y = (j & 1) ? bfhi(ypw) : bflo(ypw), s = (j & 1) ? bfhi(sgw) : bflo(sgw);
                        o[j] = y * sigmoidf_(a) * s;
                    }
                    u32x4 w0; w0.x = pk2(o[0], o[1]); w0.y = pk2(o[2], o[3]); w0.z = pk2(o[4], o[5]); w0.w = pk2(o[6], o[7]);
                    *(u32x4*)(Ya + (size_t)row * WM + c) = w0;
                }
            __builtin_amdgcn_sched_barrier(0);
        }
        return true;
    }
};
struct EpiBr {
    const bf16_t* Z; bf16_t* Mrg;
    __device__ __forceinline__ bool operator()(f32x4 (&acc)[2][2][4][2], const Unit& u, int wr, int wc, int fr, int fq) const {
        const int br = u.br, nb = br < 2 ? br + 1 : br;
#pragma unroll
        for (int ai = 0; ai < 2; ++ai) {
            u32x4 ga[4][2], gb[4][2];
#pragma unroll
            for (int m = 0; m < 4; ++m)
#pragma unroll
                for (int bj = 0; bj < 2; ++bj) {
                    const int row = u.pm * 256 + ai * 128 + wr * 64 + m * 16 + fr, c = u.pn * 256 + bj * 128 + wc * 32 + 8 * fq;
                    const bf16_t* gp = Z + (size_t)row * ZW + 9216 + c;
                    ga[m][bj] = *(const u32x4*)(gp + br * 2048); gb[m][bj] = *(const u32x4*)(gp + nb * 2048);
                }
            __builtin_amdgcn_sched_barrier(0);
#pragma unroll
            for (int m = 0; m < 4; ++m)
#pragma unroll
                for (int bj = 0; bj < 2; ++bj) {
                    const int row = u.pm * 256 + ai * 128 + wr * 64 + m * 16 + fr, c = u.pn * 256 + bj * 128 + wc * 32 + 8 * fq;
                    if (br < 2) {
#pragma unroll
                        for (int j = 0; j < 8; ++j) {
                            const unsigned aw = ga[m][bj][j >> 1], bw = gb[m][bj][j >> 1];
                            const float x = (j & 1) ? bfhi(aw) : bflo(aw), y = (j & 1) ? bfhi(bw) : bflo(bw);
                            const float r = x * __builtin_amdgcn_rcpf(fmaxf(y, 1e-30f));
                            if (j < 4) acc[ai][bj][m][0][j] *= r; else acc[ai][bj][m][1][j - 4] *= r;
                        }
                    } else {
                        float o[8];
#pragma unroll
                        for (int j = 0; j < 8; ++j) {
                            const unsigned aw = ga[m][bj][j >> 1];
                            const float x = (j & 1) ? bfhi(aw) : bflo(aw);
                            o[j] = (j < 4 ? acc[ai][bj][m][0][j] : acc[ai][bj][m][1][j - 4]) * x;
                        }
                        u32x4 w0; w0.x = pk2(o[0], o[1]); w0.y = pk2(o[2], o[3]); w0.z = pk2(o[4], o[5]); w0.w = pk2(o[6], o[7]);
                        *(u32x4*)(Mrg + (size_t)row * DM + c) = w0;
                    }
                }
            __builtin_amdgcn_sched_barrier(0);
        }
        return br == 2;
    }
};
struct EpiOut {
    const float* Xin; bf16_t* Xb; u64* ssq;
    __device__ __forceinline__ bool operator()(f32x4 (&acc)[2][2][4][2], const Unit& u, int wr, int wc, int fr, int fq) const {
        const bool first = Xin != nullptr;
#pragma unroll
        for (int ai = 0; ai < 2; ++ai) {
            if (first) {
                f32x4 xi[4][2][2];
#pragma unroll
                for (int m = 0; m < 4; ++m)
#pragma unroll
                    for (int bj = 0; bj < 2; ++bj) {
                        const int row = u.pm * 256 + ai * 128 + wr * 64 + m * 16 + fr, c = u.pn * 256 + bj * 128 + wc * 32 + 8 * fq;
                        xi[m][bj][0] = *(const f32x4*)(Xin + (size_t)row * DM + c); xi[m][bj][1] = *(const f32x4*)(Xin + (size_t)row * DM + c + 4);
                    }
                __builtin_amdgcn_sched_barrier(0);
#pragma unroll
                for (int m = 0; m < 4; ++m)
#pragma unroll
                    for (int bj = 0; bj < 2; ++bj) { acc[ai][bj][m][0] += xi[m][bj][0]; acc[ai][bj][m][1] += xi[m][bj][1]; }
            } else {
                u32x4 xw[4][2];
#pragma unroll
                for (int m = 0; m < 4; ++m)
#pragma unroll
                    for (int bj = 0; bj < 2; ++bj) {
                        const int row = u.pm * 256 + ai * 128 + wr * 64 + m * 16 + fr, c = u.pn * 256 + bj * 128 + wc * 32 + 8 * fq;
                        xw[m][bj] = *(const u32x4*)(Xb + (size_t)row * DM + c);
                    }
                __builtin_amdgcn_sched_barrier(0);
#pragma unroll
                for (int m = 0; m < 4; ++m)
#pragma unroll
                    for (int bj = 0; bj < 2; ++bj) {
                        const u32x4 w = xw[m][bj];
                        acc[ai][bj][m][0] += (f32x4){bflo(w.x), bfhi(w.x), bflo(w.y), bfhi(w.y)}; acc[ai][bj][m][1] += (f32x4){bflo(w.z), bfhi(w.z), bflo(w.w), bfhi(w.w)};
                    }
            }
#pragma unroll
            for (int m = 0; m < 4; ++m) {
                const int row = u.pm * 256 + ai * 128 + wr * 64 + m * 16 + fr;
                float part = 0.f;
#pragma unroll
                for (int bj = 0; bj < 2; ++bj) {
                    const int c = u.pn * 256 + bj * 128 + wc * 32 + 8 * fq;
                    const f32x4 v0 = acc[ai][bj][m][0], v1 = acc[ai][bj][m][1];
                    u32x4 w0; w0.x = pk2(v0[0], v0[1]); w0.y = pk2(v0[2], v0[3]); w0.z = pk2(v1[0], v1[1]); w0.w = pk2(v1[2], v1[3]);
                    *(u32x4*)(Xb + (size_t)row * DM + c) = w0;
                    part += v0[0] * v0[0] + v0[1] * v0[1] + v0[2] * v0[2] + v0[3] * v0[3] + v1[0] * v1[0] + v1[1] * v1[1] + v1[2] * v1[2] + v1[3] * v1[3];
                }
                part += __shfl_xor(part, 16); part += __shfl_xor(part, 32);
                if (fq == 0) atomicAdd(ssq + row, (u64)(part * 16777216.0f));
            }
            __builtin_amdgcn_sched_barrier(0);
        }
        return true;
    }
};

__device__ __forceinline__ void mma32(f32x16& acc, const LAS bf16_t* A, int lda, const LAS bf16_t* Bt, int ldb, int K, int lane) {
    const int r = lane & 31, h = lane >> 5;
    const LAS bf16_t* pa = A + r * lda + 8 * h; const LAS bf16_t* pb = Bt + r * ldb + 8 * h;
    for (int k = 0; k < K; k += 16) {
        const bf16x8 a = *(const LAS bf16x8*)(pa + k); const bf16x8 b = *(const LAS bf16x8*)(pb + k);
        acc = __builtin_amdgcn_mfma_f32_32x32x16_bf16(a, b, acc, 0, 0, 0);
    }
}
__device__ __forceinline__ int row32(int reg, int lane) { return (reg & 3) + 8 * (reg >> 2) + 4 * (lane >> 5); }

__device__ __forceinline__ void transpose_item(const float* W, int K, int N, bf16_t* WT, const float* scale, LAS float* scr, int item, int lane) {
    const int nkb = K / 64, kb = item % nkb, nb = item / nkb, k0 = 64 * kb, n0 = 64 * nb;
    const int r = lane >> 4, c4 = lane & 15;
    f32x4 vv[16];
#pragma unroll
    for (int i = 0; i < 16; ++i) vv[i] = *(const f32x4*)(W + (size_t)(k0 + 4 * i + r) * N + n0 + 4 * c4);
    if (scale) {
#pragma unroll
        for (int i = 0; i < 16; ++i) vv[i] = vv[i] * scale[k0 + 4 * i + r];
    }
#pragma unroll
    for (int i = 0; i < 16; ++i) {
        LAS float* d = scr + (4 * i + r) * 65 + 4 * c4;
        d[0] = vv[i][0]; d[1] = vv[i][1]; d[2] = vv[i][2]; d[3] = vv[i][3];
    }
    LDS_WAIT();
    const int cch = lane & 7;
#pragma unroll
    for (int j = 0; j < 8; ++j) { const int n = (lane >> 3) + 8 * j; const LAS float* s = scr + (8 * cch) * 65 + n;
        u32x4 o; o.x = pk2(s[0], s[65]); o.y = pk2(s[2 * 65], s[3 * 65]); o.z = pk2(s[4 * 65], s[5 * 65]); o.w = pk2(s[6 * 65], s[7 * 65]);
        *(u32x4*)(WT + (size_t)(n0 + n) * K + k0 + 8 * cch) = o; }
    LDS_WAIT();
}

struct Args { const float* in[25]; float* out; unsigned char* ws; };

__device__ __forceinline__ void phase_prep(const Args& a, LAS unsigned char* lds) {
    const int tid = opaque_tid(), lane = tid & 63, wave = tid >> 6;
    unsigned char* ws = a.ws;
    {
        LAS float* scr = (LAS float*)(lds + wave * 16640);
        const int gw = blockIdx.x * 8 + wave, NGW = gridDim.x * 8;
        constexpr int I_IN = 32 * 224, I_GLU = 16 * 16, I_BR = 16 * 32, I_OUT = 32 * 32, I_L = I_IN + I_GLU + 3 * I_BR + I_OUT;
        for (int it = gw; it < DEPTH * I_L; it += NGW) {
            const int l = it / I_L; int r = it % I_L;
            if (r < I_IN) { transpose_item(a.in[2] + (size_t)l * DM * NIN, DM, NIN, (bf16_t*)(ws + OFF_WIN) + (size_t)l * NIN * DM, a.in[1] + l * DM, scr, r, lane); continue; } r -= I_IN;
            if (r < I_GLU) { transpose_item(a.in[11] + (size_t)l * WM * WM, WM, WM, (bf16_t*)(ws + OFF_WGLU) + (size_t)l * WM * WM, nullptr, scr, r, lane); continue; } r -= I_GLU;
            if (r < 3 * I_BR) { const int br = r / I_BR; r %= I_BR;
                transpose_item(a.in[22] + ((size_t)l * 3 + br) * WM * DM, WM, DM, (bf16_t*)(ws + OFF_WBR) + ((size_t)l * 3 + br) * DM * WM, nullptr, scr, r, lane); continue; } r -= 3 * I_BR;
            transpose_item(a.in[23] + (size_t)l * DM * DM, DM, DM, (bf16_t*)(ws + OFF_WOUT) + (size_t)l * DM * DM, nullptr, scr, r, lane);
        }
    }
    {
        const float* x = a.in[0]; bf16_t* xb = (bf16_t*)(ws + OFF_XB); u64* ssq = (u64*)(ws + OFF_SSQ);
        for (int row = blockIdx.x * 8 + wave; row < T_TOK; row += gridDim.x * 8) {
            float s = 0.f;
#pragma unroll
            for (int j = 0; j < 8; ++j) {
                const f32x4 v = *(const f32x4*)(x + (size_t)row * DM + 4 * lane + 256 * j);
                s += v[0] * v[0] + v[1] * v[1] + v[2] * v[2] + v[3] * v[3];
                u32x2 w; w.x = pk2(v[0], v[1]); w.y = pk2(v[2], v[3]);
                *(u32x2*)(xb + (size_t)row * DM + 4 * lane + 256 * j) = w;
            }
#pragma unroll
            for (int o = 1; o < 64; o <<= 1) s += __shfl_xor(s, o);
            if (lane == 0) ssq[row] = (u64)(s * 16777216.0f);
        }
    }
    const int gt = blockIdx.x * 512 + tid, NT = gridDim.x * 512;
    { u64* ssq = (u64*)(ws + OFF_SSQ) + T_TOK; for (int i = gt; i < 4 * T_TOK; i += NT) ssq[i] = 0ull; }
    for (int i = gt; i < WM; i += NT) {
        const float* hb = a.in[20]; const float v0 = hb[i], v1 = hb[WM + i], v2 = hb[2 * WM + i], v3 = hb[3 * WM + i];
        const float mx = fmaxf(fmaxf(v0, v1), fmaxf(v2, v3));
        const float e0 = expf(v0 - mx), e1 = expf(v1 - mx), e2 = expf(v2 - mx), e3 = expf(v3 - mx), inv = 1.0f / (e0 + e1 + e2 + e3);
        float* lbs = (float*)(ws + OFF_LBS);
        lbs[i] = 0.f; lbs[WM + i] = e1 * inv; lbs[2 * WM + i] = (e1 + e2) * inv; lbs[3 * WM + i] = (e1 + e2 + e3) * inv;
    }
    for (int i = gt; i < DEPTH * 64 * 64; i += NT) {
        const int l = i >> 12, g = (i >> 6) & 63, p = i & 63;
        const float lre = a.in[3][i], lim = a.in[4][i], step = expf(a.in[5][l * 64 + g]);
        const float mag = expf(lre * step), ang = lim * step;
        const float are = mag * cosf(ang), aim = mag * sinf(ang);
        const float nre = are - 1.0f, nim = aim, den = lre * lre + lim * lim;
        const float cre = (nre * lre + nim * lim) / den, cim = (nim * lre - nre * lim) / den;
        ((float2*)(ws + OFF_S5A))[i] = make_float2(are, aim);
        const float* bre = a.in[6] + (size_t)i * 16; const float* bim = a.in[7] + (size_t)i * 16;
        bf16_t* bt = (bf16_t*)(ws + OFF_S5BT) + ((size_t)(l * 64 + g) * 128) * 16;
        bf16_t* ct = (bf16_t*)(ws + OFF_S5CT) + ((size_t)(l * 64 + g) * 16) * 128;
        const float* cr = a.in[8] + (size_t)(l * 64 + g) * 16 * 64; const float* ci = a.in[9] + (size_t)(l * 64 + g) * 16 * 64;
#pragma unroll 4
        for (int h = 0; h < 16; ++h) {
            const float br_ = bre[h], bi_ = bim[h];
            bt[(size_t)(2 * p) * 16 + h] = f2bf(cre * br_ - cim * bi_);
            bt[(size_t)(2 * p + 1) * 16 + h] = f2bf(cre * bi_ + cim * br_);
            ct[(size_t)h * 128 + 2 * p] = f2bf(cr[h * 64 + p]);
            ct[(size_t)h * 128 + 2 * p + 1] = f2bf(-ci[h * 64 + p]);
        }
    }
    for (int i = gt; i < DEPTH * 16 * 128 * 64; i += NT) {
        const int ii = i & 63, j = (i >> 6) & 127, ln = i >> 13;
        const float v = j < 64 ? a.in[15][(size_t)ln * 4096 + ii * 64 + j] : a.in[17][(size_t)ln * 4096 + ii * 64 + (j - 64)];
        ((bf16_t*)(ws + OFF_RGW))[i] = f2bf(v);
    }
}

__device__ __forceinline__ void s5_item(LAS unsigned char* lds, const bf16_t* Z, bf16_t* Ypre, const float2* abar, const bf16_t* BT, const bf16_t* CT, const float* dvec, int b, int g) {
    const int tid = opaque_tid(), lane = tid & 63, w = __builtin_amdgcn_readfirstlane(tid >> 6);
    const int r = lane & 31, h = lane >> 5;
    const size_t Rb = (size_t)b * SEQ;
    if (w >= 4) {
        const int nt = w - 4;
        const bf16x8 bfrag = *(const bf16x8*)(BT + (size_t)(32 * nt + r) * 16 + 8 * h);
        const bf16_t* zA = Z + (Rb + r) * ZW + g * 16 + 8 * h;
        bf16x8 a0n = *(const bf16x8*)zA, a1n = *(const bf16x8*)(zA + (size_t)32 * ZW);
#pragma unroll 1
        for (int it = 0; it < 66; ++it) {
            if (it < 64) {
                const bf16x8 a0 = a0n, a1 = a1n;
                if (it + 1 < 64) { a0n = *(const bf16x8*)(zA + (size_t)(64 * (it + 1)) * ZW); a1n = *(const bf16x8*)(zA + (size_t)(64 * (it + 1) + 32) * ZW); }
                LAS float* BU = (LAS float*)(lds + (it & 1) * 32768);
                f32x16 acc;
#pragma unroll
                for (int i = 0; i < 16; ++i) acc[i] = 0.f;
                acc = __builtin_amdgcn_mfma_f32_32x32x16_bf16(a0, bfrag, acc, 0, 0, 0);
#pragma unroll
                for (int reg = 0; reg < 16; ++reg) BU[row32(reg, lane) * 128 + 32 * nt + r] = acc[reg];
#pragma unroll
                for (int i = 0; i < 16; ++i) acc[i] = 0.f;
                acc = __builtin_amdgcn_mfma_f32_32x32x16_bf16(a1, bfrag, acc, 0, 0, 0);
#pragma unroll
                for (int reg = 0; reg < 16; ++reg) BU[(32 + row32(reg, lane)) * 128 + 32 * nt + r] = acc[reg];
            }
            __syncthreads();
        }
    } else if (w == 0) {
        const float2 ab = abar[lane];
        float xr = 0.f, xi = 0.f;
        __builtin_amdgcn_s_setprio(3);
#pragma unroll 1
        for (int it = 0; it < 66; ++it) {
            if (it >= 1 && it <= 64) {
                const LAS float* BU = (const LAS float*)(lds + ((it - 1) & 1) * 32768);
                LAS bf16_t* XS = (LAS bf16_t*)(lds + 65536 + ((it - 1) & 1) * 17408);
                f32x2 bb[2][16];
#pragma unroll
                for (int i = 0; i < 16; ++i) bb[0][i] = *(const LAS f32x2*)(BU + i * 128 + 2 * lane);
#pragma unroll
                for (int tb = 0; tb < 4; ++tb) {
                    if (tb < 3) {
#pragma unroll
                        for (int i = 0; i < 16; ++i) bb[(tb + 1) & 1][i] = *(const LAS f32x2*)(BU + (16 * (tb + 1) + i) * 128 + 2 * lane);
                    }
#pragma unroll
                    for (int i = 0; i < 16; ++i) {
                        const f32x2 bv = bb[tb & 1][i];
                        float t1 = __builtin_fmaf(-ab.y, xi, bv.x), t2 = __builtin_fmaf(ab.y, xr, bv.y);
                        asm("" : "+v"(t1)); asm("" : "+v"(t2));
                        const float nr = __builtin_fmaf(ab.x, xr, t1), ni = __builtin_fmaf(ab.x, xi, t2);
                        xr = nr; xi = ni;
                        *(LAS unsigned*)(XS + (16 * tb + i) * 136 + 2 * lane) = pk2(xr, xi);
                    }
                }
            }
            __syncthreads();
        }
        __builtin_amdgcn_s_setprio(0);
    } else {
        const int nty = w == 1 ? 2 : 1, ty0 = w == 1 ? 0 : w;
        bf16x8 cfrag[4];
#pragma unroll
        for (int ks = 0; ks < 4; ++ks) cfrag[ks] = *(const bf16x8*)(CT + (size_t)(lane & 15) * 128 + 32 * ks + 8 * (lane >> 4));
        const float dd = dvec[g * 16 + (lane & 15)];
        const bf16_t* zU = Z + (Rb + (lane >> 4) * 4) * ZW + g * 16 + (lane & 15);
        bf16_t un[2][4];
#pragma unroll
        for (int q = 0; q < 2; ++q)
#pragma unroll
            for (int reg = 0; reg < 4; ++reg) un[q][reg] = (q < nty) ? zU[(size_t)(16 * (ty0 + q) + reg) * ZW] : (bf16_t)0;
#pragma unroll 1
        for (int it = 0; it < 66; ++it) {
            if (it >= 2) {
                const int c = it - 2;
                const LAS bf16_t* XS = (const LAS bf16_t*)(lds + 65536 + (c & 1) * 17408);
                bf16_t uc[2][4];
#pragma unroll
                for (int q = 0; q < 2; ++q)
#pragma unroll
                    for (int reg = 0; reg < 4; ++reg) uc[q][reg] = un[q][reg];
                if (c + 1 < 64) {
#pragma unroll
                    for (int q = 0; q < 2; ++q)
#pragma unroll
                        for (int reg = 0; reg < 4; ++reg) if (q < nty) un[q][reg] = zU[(size_t)(64 * (c + 1) + 16 * (ty0 + q) + reg) * ZW];
                }
#pragma unroll
                for (int q = 0; q < 2; ++q) {
                    if (q < nty) {
                        const int ty = ty0 + q;
                        f32x4 a4 = (f32x4){0.f, 0.f, 0.f, 0.f};
#pragma unroll
                        for (int ks = 0; ks < 4; ++ks) {
                            const bf16x8 av = *(const LAS bf16x8*)(XS + (16 * ty + (lane & 15)) * 136 + 32 * ks + 8 * (lane >> 4));
                            a4 = __builtin_amdgcn_mfma_f32_16x16x32_bf16(av, cfrag[ks], a4, 0, 0, 0);
                        }
#pragma unroll
                        for (int reg = 0; reg < 4; ++reg) {
                            const int t = 16 * ty + (lane >> 4) * 4 + reg, hh = lane & 15;
                            const float y = a4[reg] + dd * bf2f(uc[q][reg]);
                            const float uu = 0.7978845608f * (y + 0.044715f * y * y * y);
                            const float th = 1.0f - 2.0f * __builtin_amdgcn_rcpf(1.0f + __expf(2.0f * uu));
                            Ypre[(Rb + 64 * c + t) * WM + g * 16 + hh] = f2bf(0.5f * y * (1.0f + th));
                        }
                    }
                }
            }
            __syncthreads();
        }
    }
    __syncthreads();
}

__device__ __forceinline__ unsigned flag_ld(const unsigned* p) { return __hip_atomic_load(p, __ATOMIC_RELAXED, __HIP_MEMORY_SCOPE_AGENT); }
struct RgSetup { float cw0, cw1, cw2, cw3, cb, bias, sp8; bf16x8 wfrag[4]; };
__device__ __forceinline__ RgSetup rg_setup(const bf16_t* WgT, const float* convw, const float* convb, const float* b_a, const float* b_x, const float* lam, int n) {
    const int tid = opaque_tid(), lane = tid & 63, w = __builtin_amdgcn_readfirstlane(tid >> 6);
    RgSetup s; const int ch = n * 64 + lane;
    s.cw0 = convw[ch]; s.cw1 = convw[WM + ch]; s.cw2 = convw[2 * WM + ch]; s.cw3 = convw[3 * WM + ch]; s.cb = convb[ch];
    const int nt = w & 3, r = lane & 31, h = lane >> 5;
#pragma unroll
    for (int ks = 0; ks < 4; ++ks) s.wfrag[ks] = *(const bf16x8*)(WgT + (size_t)(32 * nt + r) * 64 + 16 * ks + 8 * h);
    const int chg = n * 64 + ((32 * nt + r) & 63);
    s.bias = nt < 2 ? b_a[chg] : b_x[chg];
    s.sp8 = 8.0f * log1pf(expf(-lam[chg]));
    return s;
}
__device__ __forceinline__ void rg_fetch(const bf16_t* Z, int b, int n, int seg, bf16_t (&xn)[11], bf16_t (&sgn)[16]) {
    const int tid = opaque_tid(), lane = tid & 63, w = __builtin_amdgcn_readfirstlane(tid >> 6);
    const int ts = 128 * seg, ch = n * 64 + lane;
    const bf16_t* zx = Z + ((size_t)b * SEQ + ts + 8 * w) * ZW + 2048 + ch;
#pragma unroll
    for (int i = 0; i < 11; ++i) xn[i] = (ts + 8 * w - 3 + i >= 0) ? zx[(ptrdiff_t)(i - 3) * ZW] : (bf16_t)0;
    const bf16_t* zs = Z + ((size_t)b * SEQ + ts + 16 * w) * ZW + 3072 + ch;
#pragma unroll
    for (int i = 0; i < 16; ++i) sgn[i] = zs[(size_t)i * ZW];
}
__device__ __forceinline__ void rg_item(LAS unsigned char* lds, const bf16_t* Z, bf16_t* Yb, const RgSetup st, int seg, int segn, int b, int n, float* summ, unsigned* flags, unsigned want,
                                        bf16_t (&xn)[11], bf16_t (&sgn)[16]) {
    const int tid = opaque_tid(), lane = tid & 63, w = __builtin_amdgcn_readfirstlane(tid >> 6);
    LAS float* XCf = (LAS float*)lds;
    LAS bf16_t* XCb = (LAS bf16_t*)(lds + 16384);
    LAS float* A_ = (LAS float*)(lds + 25600);
    LAS float* M_ = (LAS float*)(lds + 41984);
    LAS float* IX_ = (LAS float*)(lds + 58368);
    LAS float* HL = (LAS float*)(lds + 74752);
    LAS float* AC = (LAS float*)(lds + 107520);
    LAS float* HIN = (LAS float*)(lds + 140288);
    const int c = lane, oct = w, ch = n * 64 + c;
    const float cw0 = st.cw0, cw1 = st.cw1, cw2 = st.cw2, cw3 = st.cw3, cb = st.cb;
    const int mt = w >> 2, nt = w & 3, r = lane & 31, h = lane >> 5;
    const int cc = (32 * nt + r) & 63;
    const float bias = st.bias, sp8 = st.sp8;
    float hstate = 0.f, aprod = 1.f;
    const int ts = 128 * seg;
    const bf16_t* zx = Z + ((size_t)b * SEQ + ts + 8 * oct) * ZW + 2048 + ch;
    bf16_t sg[16];
#pragma unroll
    for (int i = 0; i < 16; ++i) sg[i] = sgn[i];
#pragma unroll 1
    for (int tile = 0; tile < 2; ++tile) {
        const int t0 = ts + 64 * tile;
        {
            float xv[11];
#pragma unroll
            for (int i = 0; i < 11; ++i) xv[i] = bf2f(xn[i]);
            if (tile == 0) {
                const bf16_t* zn = zx + (size_t)64 * ZW;
#pragma unroll
                for (int i = 0; i < 11; ++i) xn[i] = zn[(ptrdiff_t)(i - 3) * ZW];
            }
#pragma unroll
            for (int i = 0; i < 8; ++i) {
                const float xc = cb + cw0 * xv[i] + cw1 * xv[i + 1] + cw2 * xv[i + 2] + cw3 * xv[i + 3];
                const int t = 8 * oct + i;
                XCf[t * 64 + c] = xc; XCb[t * 72 + c] = f2bf(xc);
            }
        }
        __syncthreads();
        {
            f32x16 acc;
#pragma unroll
            for (int i = 0; i < 16; ++i) acc[i] = 0.f;
#pragma unroll
            for (int ks = 0; ks < 4; ++ks) {
                const bf16x8 av = *(const LAS bf16x8*)(XCb + (32 * mt + r) * 72 + 16 * ks + 8 * h);
                acc = __builtin_amdgcn_mfma_f32_32x32x16_bf16(av, st.wfrag[ks], acc, 0, 0, 0);
            }
#pragma unroll
            for (int reg = 0; reg < 16; ++reg) {
                const int t = 32 * mt + row32(reg, lane);
                const float s = sigmoidf_(acc[reg] + bias);
                if (nt < 2) {
                    const float la = -s * sp8; const float av = __expf(la); const float x2 = 2.0f * la;
                    const float m2 = x2 > -0.05f ? -x2 * (1.0f + x2 * (0.5f + x2 * (0.16666667f + x2 * 0.041666667f))) : 1.0f - __expf(x2);
                    float mult = sqrtf(m2); if (t0 + t == 0) mult = 1.0f;
                    A_[t * 64 + cc] = av; M_[t * 64 + cc] = mult;
                } else IX_[t * 64 + cc] = s * XCf[t * 64 + cc];
            }
        }
        __syncthreads();
        if (w == 0) {
#pragma unroll 1
            for (int tb = 0; tb < 4; ++tb) {
                float a_[16], m_[16], x_[16];
#pragma unroll
                for (int i = 0; i < 16; ++i) { const int t = 16 * tb + i; a_[i] = A_[t * 64 + c]; m_[i] = M_[t * 64 + c]; x_[i] = IX_[t * 64 + c]; }
#pragma unroll
                for (int i = 0; i < 16; ++i) {
                    hstate = a_[i] * hstate + m_[i] * x_[i]; aprod *= a_[i];
                    HL[(64 * tile + 16 * tb + i) * 64 + c] = hstate; AC[(64 * tile + 16 * tb + i) * 64 + c] = aprod;
                }
            }
        }
        __syncthreads();
    }
    const int bn = b * 16 + n;
    if (segn >= 0) rg_fetch(Z, b, n, segn, xn, sgn);
    if (w == 0) {
        float* sm = summ + ((size_t)(seg * 32 + bn)) * 128;
        __hip_atomic_store(sm + c, aprod, __ATOMIC_RELAXED, __HIP_MEMORY_SCOPE_AGENT);
        __hip_atomic_store(sm + 64 + c, hstate, __ATOMIC_RELAXED, __HIP_MEMORY_SCOPE_AGENT);
        asm volatile("s_waitcnt vmcnt(0)" ::: "memory");
        if (lane == 0) __hip_atomic_store(flags + seg * 32 + bn, want, __ATOMIC_RELAXED, __HIP_MEMORY_SCOPE_AGENT);
        float hin = 0.f;
        if (seg > 0) {
            unsigned spins = 0;
            for (;;) {
                const int ok = (lane < seg) ? (flag_ld(flags + lane * 32 + bn) >= want) : 1;
                if (__all(ok)) break;
                __builtin_amdgcn_s_sleep(2);
                if (++spins > (1u << 22)) break;
            }
#pragma unroll 1
            for (int s0 = 0; s0 < seg; s0 += 8) {
                float at[8], he[8];
#pragma unroll
                for (int q = 0; q < 8; ++q) {
                    const int s2 = (s0 + q < seg) ? s0 + q : seg - 1;
                    float* p = summ + ((size_t)(s2 * 32 + bn)) * 128;
                    at[q] = __hip_atomic_load(p + c, __ATOMIC_RELAXED, __HIP_MEMORY_SCOPE_AGENT); he[q] = __hip_atomic_load(p + 64 + c, __ATOMIC_RELAXED, __HIP_MEMORY_SCOPE_AGENT);
                }
#pragma unroll
                for (int q = 0; q < 8; ++q) if (s0 + q < seg) hin = at[q] * hin + he[q];
            }
        }
        HIN[c] = hin;
    }
    __syncthreads();
    {
        const float hin = HIN[c];
        bf16_t* yo = Yb + ((size_t)b * SEQ + ts + 16 * w) * WM + ch;
#pragma unroll
        for (int i = 0; i < 16; ++i) {
            const int t = 16 * w + i;
            yo[(size_t)i * WM] = f2bf((HL[t * 64 + c] + AC[t * 64 + c] * hin) * bf2f(sg[i]));
        }
    }
    __syncthreads();
}

__device__ __forceinline__ void hg_item(LAS unsigned char* lds, const bf16_t* Z, bf16_t* Yc, const float* normw, int b, int hd, int seg,
                                        float* OL, bf16_t* QH, float* USEG, float* DSEG, unsigned* flags, unsigned want) {
    const int tid = opaque_tid(), lane = tid & 63, w = __builtin_amdgcn_readfirstlane(tid >> 6);
    LAS float* Of = (LAS float*)lds;
    LAS bf16_t* QT = (LAS bf16_t*)(lds + 32768);
    LAS bf16_t* KT = (LAS bf16_t*)(lds + 50176);
    LAS bf16_t* KTT = (LAS bf16_t*)(lds + 67584);
    LAS bf16_t* VT = (LAS bf16_t*)(lds + 86016);
    LAS bf16_t* PP = (LAS bf16_t*)(lds + 104448);
    LAS bf16_t* ST = (LAS bf16_t*)(lds + 113664);
    LAS float* TOT = (LAS float*)(lds + 148480);
    LAS float* E1 = (LAS float*)(lds + 152576);
    LAS float* E2 = (LAS float*)(lds + 153088);
    const int t_ = tid >> 3, cg_ = (tid & 7) * 16;
    const int kp = lane;
    const int kt = w >> 1, vt0 = 2 * (w & 1);
    const int mt = w >> 2, vt = w & 3;
    const int bh = b * 8 + hd, item = seg * 16 + bh;
    const size_t Rs = (size_t)b * SEQ + 512 * seg;
    f32x16 S0, S1;
#pragma unroll
    for (int i = 0; i < 16; ++i) { S0[i] = 0.f; S1[i] = 0.f; }
    float gacc0 = 0.f, gacc1 = 0.f;
    {
    const bf16_t* zc0 = Z + (Rs + 8 * w) * ZW + hd * 128 + 2 * kp;
    unsigned nq[8], nk[8], ng[8], nv[8];
#pragma unroll
    for (int i = 0; i < 8; ++i) { const bf16_t* p = zc0 + (size_t)i * ZW; nq[i] = *(const unsigned*)(p + 4096); ng[i] = *(const unsigned*)(p + 5120); nk[i] = *(const unsigned*)(p + 6144); nv[i] = *(const unsigned*)(p + 7168); }
#pragma unroll 1
    for (int c = 0; c < 8; ++c) {
        const size_t R0 = Rs + 64 * c;
        unsigned q2[8], k2[8], v2[8]; float G0[8], G1[8];
        {
            float r0 = 0.f, r1 = 0.f;
#pragma unroll
            for (int i = 0; i < 8; ++i) { q2[i] = nq[i]; k2[i] = nk[i]; v2[i] = nv[i]; r0 += bflo(ng[i]); r1 += bfhi(ng[i]); G0[i] = r0; G1[i] = r1; }
            *(LAS f32x2*)(TOT + w * 128 + 2 * kp) = (f32x2){r0, r1};
        }
        if (c + 1 < 8) {
            const bf16_t* zn = zc0 + (size_t)(64 * (c + 1)) * ZW;
#pragma unroll
            for (int i = 0; i < 8; ++i) { const bf16_t* p = zn + (size_t)i * ZW; nq[i] = *(const unsigned*)(p + 4096); ng[i] = *(const unsigned*)(p + 5120); nk[i] = *(const unsigned*)(p + 6144); nv[i] = *(const unsigned*)(p + 7168); }
        }
        __syncthreads();
        {
            float off0 = 0.f, off1 = 0.f, gm0 = 0.f, gm1 = 0.f, gl0 = 0.f, gl1 = 0.f;
#pragma unroll
            for (int s = 0; s < 8; ++s) {
                const f32x2 tv = *(const LAS f32x2*)(TOT + s * 128 + 2 * kp);
                if (s < w) { off0 += tv.x; off1 += tv.y; }
                if (s < 4) { gm0 += tv.x; gm1 += tv.y; }
                gl0 += tv.x; gl1 += tv.y;
            }
            float ka[8], kb[8];
            bf16_t* qh = QH + (R0 + 8 * w) * WM + hd * 128 + 2 * kp;
#pragma unroll
            for (int i = 0; i < 8; ++i) {
                const float g0 = G0[i] + off0, g1 = G1[i] + off1;
                const float d0 = g0 - gm0, d1 = g1 - gm1;
                const float qf0 = bflo(q2[i]), qf1 = bfhi(q2[i]);
                const float qa = qf0 * __expf(fminf(d0, 80.f)), qb = qf1 * __expf(fminf(d1, 80.f));
                ka[i] = bflo(k2[i]) * __expf(fminf(-d0, 80.f)); kb[i] = bfhi(k2[i]) * __expf(fminf(-d1, 80.f));
                *(LAS unsigned*)(QT + (8 * w + i) * 136 + 2 * kp) = pk2(qa, qb);
                *(LAS unsigned*)(KT + (8 * w + i) * 136 + 2 * kp) = pk2(ka[i], kb[i]);
                *(unsigned*)(qh + (size_t)i * WM) = pk2(qf0 * __expf(g0 + gacc0), qf1 * __expf(g1 + gacc1));
            }
            gacc0 += gl0; gacc1 += gl1;
            u32x4 wa, wb;
            wa.x = pk2(ka[0], ka[1]); wa.y = pk2(ka[2], ka[3]); wa.z = pk2(ka[4], ka[5]); wa.w = pk2(ka[6], ka[7]);
            wb.x = pk2(kb[0], kb[1]); wb.y = pk2(kb[2], kb[3]); wb.z = pk2(kb[4], kb[5]); wb.w = pk2(kb[6], kb[7]);
            *(LAS u32x4*)(KTT + (2 * kp) * 72 + 8 * w) = wa; *(LAS u32x4*)(KTT + (2 * kp + 1) * 72 + 8 * w) = wb;
            wa.x = (v2[0] & 0xffffu) | (v2[1] << 16); wa.y = (v2[2] & 0xffffu) | (v2[3] << 16); wa.z = (v2[4] & 0xffffu) | (v2[5] << 16); wa.w = (v2[6] & 0xffffu) | (v2[7] << 16);
            wb.x = (v2[0] >> 16) | (v2[1] & 0xffff0000u); wb.y = (v2[2] >> 16) | (v2[3] & 0xffff0000u); wb.z = (v2[4] >> 16) | (v2[5] & 0xffff0000u); wb.w = (v2[6] >> 16) | (v2[7] & 0xffff0000u);
            *(LAS u32x4*)(VT + (2 * kp) * 72 + 8 * w) = wa; *(LAS u32x4*)(VT + (2 * kp + 1) * 72 + 8 * w) = wb;
            if (w == 0) { *(LAS f32x2*)(E1 + 2 * kp) = (f32x2){__expf(gm0), __expf(gm1)}; *(LAS f32x2*)(E2 + 2 * kp) = (f32x2){__expf(gl0 - gm0), __expf(gl1 - gm1)}; }
        }
        __syncthreads();
        {
            if (w < 3) {
                const int pm_ = w == 0 ? 0 : 1, ps_ = w == 2 ? 1 : 0;
                f32x16 acc;
#pragma unroll
                for (int i = 0; i < 16; ++i) acc[i] = 0.f;
                mma32(acc, QT + 32 * pm_ * 136, 136, KT + 32 * ps_ * 136, 136, 128, lane);
#pragma unroll
                for (int reg = 0; reg < 16; ++reg) { const int t = 32 * pm_ + row32(reg, lane), s = 32 * ps_ + (lane & 31);
                    PP[t * 72 + s] = f2bf(s <= t ? acc[reg] : 0.f); }
            } else if (w == 3) {
#pragma unroll
                for (int reg = 0; reg < 16; ++reg) PP[row32(reg, lane) * 72 + 32 + (lane & 31)] = 0;
            }
#pragma unroll
            for (int i = 0; i < 4; ++i) {
                const int kk0 = 32 * kt + 8 * i + 4 * (lane >> 5);
                const f32x4 e = *(const LAS f32x4*)(E1 + kk0);
#pragma unroll
                for (int j = 0; j < 4; ++j) { S0[4 * i + j] *= e[j]; S1[4 * i + j] *= e[j]; }
                u32x2 a0, a1; a0.x = pk2(S0[4 * i], S0[4 * i + 1]); a0.y = pk2(S0[4 * i + 2], S0[4 * i + 3]); a1.x = pk2(S1[4 * i], S1[4 * i + 1]); a1.y = pk2(S1[4 * i + 2], S1[4 * i + 3]);
                *(LAS u32x2*)(ST + (32 * vt0 + (lane & 31)) * 136 + kk0) = a0;
                *(LAS u32x2*)(ST + (32 * (vt0 + 1) + (lane & 31)) * 136 + kk0) = a1;
            }
        }
        __syncthreads();
        {
            f32x16 acc;
#pragma unroll
            for (int i = 0; i < 16; ++i) acc[i] = 0.f;
            mma32(acc, QT + 32 * mt * 136, 136, ST + 32 * vt * 136, 136, 128, lane);
            mma32(acc, PP + 32 * mt * 72, 72, VT + 32 * vt * 72, 72, 64, lane);
            float* ol = OL + (R0 + 32 * mt) * WM + hd * 128 + 32 * vt + (lane & 31);
#pragma unroll
            for (int reg = 0; reg < 16; ++reg) ol[(size_t)row32(reg, lane) * WM] = acc[reg];
            mma32(S0, KTT + 32 * kt * 72, 72, VT + 32 * vt0 * 72, 72, 64, lane);
            mma32(S1, KTT + 32 * kt * 72, 72, VT + 32 * (vt0 + 1) * 72, 72, 64, lane);
#pragma unroll
            for (int i = 0; i < 4; ++i) {
                const f32x4 e = *(const LAS f32x4*)(E2 + 32 * kt + 8 * i + 4 * (lane >> 5));
#pragma unroll
                for (int j = 0; j < 4; ++j) { S0[4 * i + j] *= e[j]; S1[4 * i + j] *= e[j]; }
            }
        }
    }
    }
    {
        float* us = USEG + (size_t)item * 16384 + (size_t)(32 * kt) * 128 + 32 * vt0 + (lane & 31);
#pragma unroll
        for (int reg = 0; reg < 16; ++reg) { us[row32(reg, lane) * 128] = S0[reg]; us[row32(reg, lane) * 128 + 32] = S1[reg]; }
        if (w == 0) { DSEG[item * 128 + 2 * kp] = __expf(gacc0); DSEG[item * 128 + 2 * kp + 1] = __expf(gacc1); }
        asm volatile("s_waitcnt vmcnt(0)" ::: "memory");
        __syncthreads();
        if (tid == 0) {
            __builtin_amdgcn_fence(__ATOMIC_RELEASE, "agent");
            asm volatile("s_waitcnt vmcnt(0)" ::: "memory");
            __hip_atomic_store(flags + item, want, __ATOMIC_RELAXED, __HIP_MEMORY_SCOPE_AGENT);
        }
        if (w == 0) {
            if (seg > 0) {
                unsigned spins = 0;
                for (;;) {
                    const int ok = (lane < seg) ? (flag_ld(flags + lane * 16 + bh) >= want) : 1;
                    if (__all(ok)) break;
                    __builtin_amdgcn_s_sleep(2);
                    if (++spins > (1u << 22)) break;
                }
            }
            __builtin_amdgcn_fence(__ATOMIC_ACQUIRE, "agent");
            asm volatile("s_waitcnt vmcnt(0)" ::: "memory");
        }
        __syncthreads();
    }
    {
#pragma unroll
        for (int i = 0; i < 16; ++i) { S0[i] = 0.f; S1[i] = 0.f; }
        if (seg > 0) {
            float dn[16], u0n[16], u1n[16];
            {
                const float* us = USEG + (size_t)bh * 16384 + (size_t)(32 * kt) * 128 + 32 * vt0 + (lane & 31);
                const float* ds = DSEG + bh * 128 + 32 * kt;
#pragma unroll
                for (int reg = 0; reg < 16; ++reg) { dn[reg] = ds[row32(reg, lane)]; u0n[reg] = us[row32(reg, lane) * 128]; u1n[reg] = us[row32(reg, lane) * 128 + 32]; }
            }
#pragma unroll 1
            for (int s2 = 0; s2 < seg; ++s2) {
                float dc[16], u0c[16], u1c[16];
#pragma unroll
                for (int reg = 0; reg < 16; ++reg) { dc[reg] = dn[reg]; u0c[reg] = u0n[reg]; u1c[reg] = u1n[reg]; }
                if (s2 + 1 < seg) {
                    const int it2 = (s2 + 1) * 16 + bh;
                    const float* us = USEG + (size_t)it2 * 16384 + (size_t)(32 * kt) * 128 + 32 * vt0 + (lane & 31);
                    const float* ds = DSEG + it2 * 128 + 32 * kt;
#pragma unroll
                    for (int reg = 0; reg < 16; ++reg) { dn[reg] = ds[row32(reg, lane)]; u0n[reg] = us[row32(reg, lane) * 128]; u1n[reg] = us[row32(reg, lane) * 128 + 32]; }
                }
#pragma unroll
                for (int reg = 0; reg < 16; ++reg) { S0[reg] = dc[reg] * S0[reg] + u0c[reg]; S1[reg] = dc[reg] * S1[reg] + u1c[reg]; }
            }
        }
#pragma unroll
        for (int i = 0; i < 4; ++i) {
            const int kk0 = 32 * kt + 8 * i + 4 * (lane >> 5);
            u32x2 a0, a1; a0.x = pk2(S0[4 * i], S0[4 * i + 1]); a0.y = pk2(S0[4 * i + 2], S0[4 * i + 3]); a1.x = pk2(S1[4 * i], S1[4 * i + 1]); a1.y = pk2(S1[4 * i + 2], S1[4 * i + 3]);
            *(LAS u32x2*)(ST + (32 * vt0 + (lane & 31)) * 136 + kk0) = a0;
            *(LAS u32x2*)(ST + (32 * (vt0 + 1) + (lane & 31)) * 136 + kk0) = a1;
        }
    }
    {
        float nw[16];
#pragma unroll
        for (int i = 0; i < 16; ++i) nw[i] = normw[hd * 128 + cg_ + i];
        const bf16_t* qr = QH + (Rs + t_) * WM + hd * 128 + cg_;
        const bf16_t* zr = Z + (Rs + t_) * ZW + 8192 + hd * 128 + cg_;
        u32x4 h0 = *(const u32x4*)qr, h1 = *(const u32x4*)(qr + 8);
        u32x4 s0 = *(const u32x4*)zr, s1 = *(const u32x4*)(zr + 8);
        const float* ol0 = OL + (Rs + 32 * mt) * WM + hd * 128 + 32 * vt + (lane & 31);
        float oln[16];
#pragma unroll
        for (int reg = 0; reg < 16; ++reg) oln[reg] = ol0[(size_t)row32(reg, lane) * WM];
#pragma unroll 1
        for (int c = 0; c < 8; ++c) {
            const size_t R0 = Rs + 64 * c;
            *(LAS u32x4*)(QT + t_ * 136 + cg_) = h0; *(LAS u32x4*)(QT + t_ * 136 + cg_ + 8) = h1;
            const u32x4 sc0 = s0, sc1 = s1;
            float olv[16];
#pragma unroll
            for (int reg = 0; reg < 16; ++reg) olv[reg] = oln[reg];
            if (c + 1 < 8) {
                h0 = *(const u32x4*)(qr + (size_t)(64 * (c + 1)) * WM); h1 = *(const u32x4*)(qr + (size_t)(64 * (c + 1)) * WM + 8);
                s0 = *(const u32x4*)(zr + (size_t)(64 * (c + 1)) * ZW); s1 = *(const u32x4*)(zr + (size_t)(64 * (c + 1)) * ZW + 8);
#pragma unroll
                for (int reg = 0; reg < 16; ++reg) oln[reg] = ol0[(size_t)(64 * (c + 1) + row32(reg, lane)) * WM];
            }
            __syncthreads();
            {
                f32x16 acc;
#pragma unroll
                for (int i = 0; i < 16; ++i) acc[i] = olv[i];
                mma32(acc, QT + 32 * mt * 136, 136, ST + 32 * vt * 136, 136, 128, lane);
#pragma unroll
                for (int reg = 0; reg < 16; ++reg) Of[(32 * mt + row32(reg, lane)) * 128 + 32 * vt + (lane & 31)] = acc[reg];
            }
            __syncthreads();
            {
                float o[16]; float ss = 0.f;
#pragma unroll
                for (int i = 0; i < 4; ++i) { const f32x4 v = *(const LAS f32x4*)(Of + t_ * 128 + cg_ + 4 * i); o[4 * i] = v[0]; o[4 * i + 1] = v[1]; o[4 * i + 2] = v[2]; o[4 * i + 3] = v[3]; }
#pragma unroll
                for (int i = 0; i < 16; ++i) ss += o[i] * o[i];
                ss += __shfl_xor(ss, 1); ss += __shfl_xor(ss, 2); ss += __shfl_xor(ss, 4);
                const float rs = rsqrtf(ss * (1.0f / 128.0f) + EPS);
#pragma unroll
                for (int j = 0; j < 4; ++j) {
                    o[2 * j] *= rs * nw[2 * j] * bflo(sc0[j]); o[2 * j + 1] *= rs * nw[2 * j + 1] * bfhi(sc0[j]);
                    o[8 + 2 * j] *= rs * nw[8 + 2 * j] * bflo(sc1[j]); o[8 + 2 * j + 1] *= rs * nw[8 + 2 * j + 1] * bfhi(sc1[j]);
                }
                u32x4 w0, w1;
                w0.x = pk2(o[0], o[1]); w0.y = pk2(o[2], o[3]); w0.z = pk2(o[4], o[5]); w0.w = pk2(o[6], o[7]);
                w1.x = pk2(o[8], o[9]); w1.y = pk2(o[10], o[11]); w1.z = pk2(o[12], o[13]); w1.w = pk2(o[14], o[15]);
                bf16_t* yp = Yc + (R0 + t_) * WM + hd * 128 + cg_;
                *(u32x4*)yp = w0; *(u32x4*)(yp + 8) = w1;
            }
        }
    }
    __syncthreads();
}

#define XB_TMO      128
#define XB_XCNT(j)  (256  + 64 * (j))
#define XB_XSUB(j)  (1280 + 64 * (j))
#define XB_XGEN(j)  (2304 + 64 * (j))
#define XB_TOP      3328
#define XB_TOPGEN   3392
#define XCD_BAR_WORDS 3456
#define XB_SPIN_CAP (1u << 22)
__device__ __forceinline__ unsigned xb_ld(unsigned* p)              { return __hip_atomic_load(p, __ATOMIC_RELAXED, __HIP_MEMORY_SCOPE_AGENT); }
__device__ __forceinline__ unsigned xb_add(unsigned* p, unsigned v) { return __hip_atomic_fetch_add(p, v, __ATOMIC_RELAXED, __HIP_MEMORY_SCOPE_AGENT); }
__device__ __forceinline__ unsigned xb_xcc_id() { return (unsigned)__builtin_amdgcn_s_getreg((3 << 11) | 20) & 0xFu; }
#define XB_SPIN(cond, bar) do { unsigned _sp = 0; while (cond) { __builtin_amdgcn_s_sleep(1); \
    if ((++_sp & 255u) == 0u) { if (xb_ld(&(bar)[XB_TMO])) break; if (_sp > XB_SPIN_CAP) { atomicAdd(&(bar)[XB_TMO], 1u); break; } } } } while (0)
struct XcdBarrier { unsigned* bar; unsigned x; volatile LAS unsigned* st; };
__device__ __forceinline__ XcdBarrier xcd_barrier_post(unsigned* bar, volatile LAS unsigned* st) {
    XcdBarrier b; b.bar = bar; b.x = xb_xcc_id(); b.st = st;
    if (threadIdx.x == 0) (void)xb_add(&bar[XB_XCNT(b.x)], 1u);
    return b;
}
__device__ __forceinline__ void xcd_barrier_complete(unsigned* bar, unsigned x, unsigned& nloc, unsigned& nx) {
    const unsigned G = gridDim.x * gridDim.y * gridDim.z;
    unsigned sum, cnt, mine, sp = 0u;
    for (;;) {
        sum = 0u; cnt = 0u; mine = 0u;
#pragma unroll
        for (unsigned j = 0; j < 16; ++j) { const unsigned c = xb_ld(&bar[XB_XCNT(j)]); sum += c; cnt += (c > 0u) ? 1u : 0u; mine = (j == x) ? c : mine; }
        if (sum == G) break;
        __builtin_amdgcn_s_sleep(1);
        if ((++sp & 255u) == 0u) { if (xb_ld(&bar[XB_TMO])) break; if (sp > XB_SPIN_CAP) { atomicAdd(&bar[XB_TMO], 1u); break; } }
    }
    nloc = mine > 0u ? mine : 1u; nx = cnt > 0u ? cnt : 1u;
}
__device__ __forceinline__ void xcd_barrier(const XcdBarrier& b) {
    asm volatile("s_waitcnt vmcnt(0)" ::: "memory");
    __syncthreads();
    if (threadIdx.x == 0) {
        unsigned* bar = b.bar;
        __builtin_amdgcn_s_waitcnt(0);
        unsigned nloc = b.st[0], nx = b.st[1];
        if (nloc == 0u) { xcd_barrier_complete(bar, b.x, nloc, nx); b.st[0] = nloc; b.st[1] = nx; }
        const unsigned old = xb_add(&bar[XB_XSUB(b.x)], 1u);
        const unsigned gen = old / nloc;
        if (old + 1u == (gen + 1u) * nloc) {
            __builtin_amdgcn_fence(__ATOMIC_RELEASE, "agent");
            asm volatile("s_waitcnt vmcnt(0)" ::: "memory");
            const unsigned og = xb_add(&bar[XB_TOP], 1u);
            const unsigned tg = og / nx;
            if (og + 1u == (tg + 1u) * nx) xb_add(&bar[XB_TOPGEN], 1u);
            else XB_SPIN(xb_ld(&bar[XB_TOPGEN]) == tg, bar);
            __builtin_amdgcn_fence(__ATOMIC_ACQUIRE, "agent");
            xb_add(&bar[XB_XGEN(b.x)], 1u);
            asm volatile("s_waitcnt vmcnt(0)" ::: "memory");
        } else {
            XB_SPIN(xb_ld(&bar[XB_XGEN(b.x)]) == gen, bar);
            __builtin_amdgcn_fence(__ATOMIC_ACQUIRE, "agent");
            asm volatile("s_waitcnt vmcnt(0)" ::: "memory");
        }
    }
    __syncthreads();
}

extern "C" __global__ void __launch_bounds__(512, 2) mk_fwd(Args a) {
    extern __shared__ __attribute__((aligned(16))) unsigned char shm[];
    LAS unsigned char* lds = (LAS unsigned char*)shm;
    cg::grid_group grid = cg::this_grid();
    unsigned char* ws = a.ws;
    volatile LAS unsigned* xst = (volatile LAS unsigned*)(lds + LDS_BYTES - 16);
    if (threadIdx.x == 0) { xst[0] = 0u; xst[1] = 0u; }
    __syncthreads();
    const XcdBarrier xb = xcd_barrier_post((unsigned*)(ws + OFF_BAR), xst);
    const int G = gridDim.x, bid = blockIdx.x;
    u64* ssq = (u64*)(ws + OFF_SSQ);
    bf16_t* Xb = (bf16_t*)(ws + OFF_XB);
    bf16_t* Z = (bf16_t*)(ws + OFF_Z);
    bf16_t* Ypre = (bf16_t*)(ws + OFF_YPRE);
    bf16_t* Y3 = (bf16_t*)(ws + OFF_Y3);
    bf16_t* Mrg = (bf16_t*)(ws + OFF_MRG);

    phase_prep(a, lds);
    grid.sync();

#pragma unroll 1
    for (int l = 0; l < DEPTH; ++l) {
        {
            pg8::Gemm g{Xb, (const bf16_t*)(ws + OFF_WIN) + (size_t)l * NIN * DM, T_TOK, NIN, DM, 0, 0};
            pg8::StaticOrder S; S.init(T_TOK, NIN, G, bid);
            EpiZ E{Z, ssq + l * T_TOK, (const float*)(ws + OFF_LBS) + l * WM};
            pg8::gemm_phase(lds, g, S, E);
        }
        GSYNC();
        {
            {
                const int bn0 = bid & 31, n0 = bn0 & 15;
                const RgSetup st = rg_setup((const bf16_t*)(ws + OFF_RGW) + (size_t)(l * 16 + n0) * 8192, a.in[13] + l * 4 * WM, a.in[14] + l * WM,
                                            a.in[16] + l * WM, a.in[18] + l * WM, a.in[19] + l * WM, n0);
                const int nit = bid < 128 ? 3 : 5, b0 = bn0 >> 4;
                bf16_t xn[11], sgn[16];
                rg_fetch(Z, b0, n0, bid >> 5, xn, sgn);
#pragma unroll 1
                for (int j = 0; j < nit; ++j) {
                    const int it = j < 3 ? bid + 256 * j : 768 + (bid - 128) + 128 * (j - 3);
                    const int jn = j + 1, itn = jn < 3 ? bid + 256 * jn : 768 + (bid - 128) + 128 * (jn - 3);
                    rg_item(lds, Z, Y3 + (size_t)T_TOK * WM, st, it >> 5, jn < nit ? (itn >> 5) : -1, b0, n0, (float*)(ws + OFF_RGS), (unsigned*)(ws + OFF_FLG), (unsigned)(l + 1), xn, sgn);
                }
            }
            if (bid < 128) {
                const int b = bid >> 6, g = bid & 63;
                s5_item(lds, Z, Ypre, (const float2*)(ws + OFF_S5A) + (l * 64 + g) * 64, (const bf16_t*)(ws + OFF_S5BT) + (size_t)(l * 64 + g) * 2048,
                        (const bf16_t*)(ws + OFF_S5CT) + (size_t)(l * 64 + g) * 2048, a.in[10] + l * WM, b, g);
                {
                    pg8::Gemm g2{Ypre, (const bf16_t*)(ws + OFF_WGLU) + (size_t)l * WM * WM, T_TOK, WM, WM, 0, 0};
                    pg8::StaticOrder S; S.init(T_TOK, WM, 128, bid);
                    pg8::Unit u0; S.next(0, u0);
                    unsigned* s5cnt = (unsigned*)(ws + OFF_FLG) + 2048;
                    asm volatile("s_waitcnt vmcnt(0)" ::: "memory");
                    __syncthreads();
                    if (threadIdx.x == 0) {
                        __builtin_amdgcn_fence(__ATOMIC_RELEASE, "agent");
                        asm volatile("s_waitcnt vmcnt(0)" ::: "memory");
                        __hip_atomic_fetch_add(s5cnt + 64 * b, 1u, __ATOMIC_RELAXED, __HIP_MEMORY_SCOPE_AGENT);
                        unsigned spins = 0;
                        while (__hip_atomic_load(s5cnt + 64 * (u0.pm >> 4), __ATOMIC_RELAXED, __HIP_MEMORY_SCOPE_AGENT) < 64u * (unsigned)(l + 1)) {
                            __builtin_amdgcn_s_sleep(2); if (++spins > (1u << 22)) break; }
                        __builtin_amdgcn_fence(__ATOMIC_ACQUIRE, "agent");
                        asm volatile("s_waitcnt vmcnt(0)" ::: "memory");
                    }
                    __syncthreads();
                    EpiGlu E{Ypre, Z, a.in[12] + l * WM, Y3};
                    pg8::gemm_phase(lds, g2, S, E);
                }
            } else {
                const int i = bid - 128, seg = i >> 4, bh = i & 15;
                hg_item(lds, Z, Y3 + (size_t)2 * T_TOK * WM, a.in[21] + l * WM, bh >> 3, bh & 7, seg, (float*)(ws + OFF_OL), (bf16_t*)(ws + OFF_QH),
                        (float*)(ws + OFF_USEG), (float*)(ws + OFF_DSEG), (unsigned*)(ws + OFF_FLG) + 1024, (unsigned)(l + 1));
            }
        }
        GSYNC();
        {
            pg8::Gemm g{Y3, (const bf16_t*)(ws + OFF_WBR) + (size_t)l * 3 * DM * WM, T_TOK, DM, WM, (size_t)T_TOK * WM * 2, (size_t)DM * WM * 2};
            pg8::Order3 S; S.init(T_TOK, DM, G, bid);
            EpiBr E{Z, Mrg};
            pg8::gemm_phase(lds, g, S, E);
        }
        GSYNC();
        {
            pg8::Gemm g{Mrg, (const bf16_t*)(ws + OFF_WOUT) + (size_t)l * DM * DM, T_TOK, DM, DM, 0, 0};
            pg8::StaticOrder S; S.init(T_TOK, DM, G, bid);
            EpiOut E{l == 0 ? a.in[0] : nullptr, Xb, ssq + (l + 1) * T_TOK};
            pg8::gemm_phase(lds, g, S, E);
        }
        GSYNC();
    }
    {
        const int tid = opaque_tid(), lane = tid & 63, wave = tid >> 6;
        const float* fw = a.in[24]; const u64* sq = ssq + 4 * T_TOK;
        for (int row = bid * 8 + wave; row < T_TOK; row += G * 8) {
            const float rs = ssq_rstd(sq + row);
#pragma unroll
            for (int j = 0; j < 8; ++j) {
                const int col = 4 * lane + 256 * j;
                const u32x2 xw = *(const u32x2*)(Xb + (size_t)row * DM + col); const f32x4 v = (f32x4){bflo(xw.x), bfhi(xw.x), bflo(xw.y), bfhi(xw.y)}; const f32x4 wv = *(const f32x4*)(fw + col);
                *(f32x4*)(a.out + (size_t)row * DM + col) = v * rs * wv;
            }
        }
    }
}

extern "C" void kernel_launch(void* const* d_in, const int* in_sizes, int n_in, void* d_out, int out_size, void* d_ws, size_t ws_size, hipStream_t stream) {
    static int grid = 0;
    if (grid == 0) {
        if (n_in != 25 || ws_size < WS_END) { fprintf(stderr, "kernel_launch: unexpected n_in %d or ws_size %zu (need %zu)\n", n_in, ws_size, (size_t)WS_END); grid = -1; return; }
        int dev = 0, cus = 0, per = 0;
        (void)hipGetDevice(&dev); (void)hipDeviceGetAttribute(&cus, hipDeviceAttributeMultiprocessorCount, dev);
        if (hipFuncSetAttribute((const void*)mk_fwd, hipFuncAttributeMaxDynamicSharedMemorySize, LDS_BYTES) != hipSuccess) fprintf(stderr, "kernel_launch: hipFuncSetAttribute failed\n");
        (void)hipOccupancyMaxActiveBlocksPerMultiprocessor(&per, (const void*)mk_fwd, 512, LDS_BYTES);
        (void)hipGetLastError();
        grid = cus > 0 ? cus : 256;
        if (grid > 256) grid = 256;
    }
    if (grid < 0) return;
    (void)hipMemsetAsync((unsigned char*)d_ws + OFF_BAR, 0, 32768, stream);
    Args a{};
    for (int i = 0; i < 25; ++i) a.in[i] = (const float*)d_in[i];
    a.out = (float*)d_out; a.ws = (unsigned char*)d_ws;
    void* args[] = {&a};
    hipError_t e = hipLaunchCooperativeKernel((void*)mk_fwd, dim3(grid), dim3(512), args, LDS_BYTES, stream);
    if (e != hipSuccess) fprintf(stderr, "cooperative launch failed: %s (grid %d)\n", hipGetErrorString(e), grid);
}
```

```cpp
#include <hip/hip_runtime.h>
#include <hip/hip_cooperative_groups.h>
#include <cstdio>
#include <cstdint>
namespace cg = cooperative_groups;
#define GSYNC() xcd_barrier(xb)

#define LAS __attribute__((address_space(3)))
typedef unsigned short bf16_t;
typedef short bf16x8 __attribute__((ext_vector_type(8)));
typedef float f32x4 __attribute__((ext_vector_type(4)));
typedef float f32x16 __attribute__((ext_vector_type(16)));
typedef unsigned u32x4 __attribute__((ext_vector_type(4)));
typedef unsigned u32x2 __attribute__((ext_vector_type(2)));
typedef unsigned long long u64;
typedef float f32x2 __attribute__((ext_vector_type(2)));
__device__ __forceinline__ float ssq_rstd(const u64* p) { return rsqrtf((float)(*p) * (1.0f / (16777216.0f * 2048.0f)) + 1e-6f); }

constexpr int T_TOK = 8192, SEQ = 4096, DM = 2048, WM = 1024, NIN = 14336, DEPTH = 4;
constexpr int ZW = 15360;
constexpr float EPS = 1e-6f;
constexpr int LDS_BYTES = 163840;

constexpr size_t OFF_SSQ = 0;
constexpr size_t OFF_LBS = 327680;
constexpr size_t OFF_S5A = 344064;
constexpr size_t OFF_S5BT = 475136;
constexpr size_t OFF_S5CT = 1523712;
constexpr size_t OFF_RGW = 2572288;
constexpr size_t OFF_BAR = 3670016;
constexpr size_t OFF_WIN = 4194304;
constexpr size_t OFF_WGLU = OFF_WIN + 234881024ull;
constexpr size_t OFF_WBR = OFF_WGLU + 8388608ull;
constexpr size_t OFF_WOUT = OFF_WBR + 50331648ull;
constexpr size_t OFF_X = OFF_WOUT + 33554432ull;
constexpr size_t OFF_XB = OFF_X + 67108864ull;
constexpr size_t OFF_Z = OFF_XB + 33554432ull;
constexpr size_t OFF_YPRE = OFF_Z + 251658240ull;
constexpr size_t OFF_Y3 = OFF_YPRE + 16777216ull;
constexpr size_t OFF_MRG = OFF_Y3 + 50331648ull;
constexpr size_t OFF_RGS = OFF_MRG + 33554432ull;
constexpr size_t OFF_OL = OFF_RGS + 524288ull;
constexpr size_t OFF_QH = OFF_OL + 33554432ull;
constexpr size_t OFF_USEG = OFF_QH + 16777216ull;
constexpr size_t OFF_DSEG = OFF_USEG + 8388608ull;
constexpr size_t WS_END = OFF_DSEG + 65536ull;
constexpr size_t OFF_FLG = OFF_BAR + 16384;

__device__ __forceinline__ unsigned pk2(float lo, float hi) { unsigned r; asm("v_cvt_pk_bf16_f32 %0, %1, %2" : "=v"(r) : "v"(lo), "v"(hi)); return r; }
__device__ __forceinline__ unsigned pk2t(float lo, float hi) { unsigned r; asm("s_nop 1\n\tv_cvt_pk_bf16_f32 %0, %1, %2" : "=v"(r) : "v"(lo), "v"(hi)); return r; }
__device__ __forceinline__ bf16_t f2bf(float f) { return (bf16_t)(pk2(f, 0.f) & 0xffffu); }
__device__ __forceinline__ float bf2f(bf16_t b) { return __uint_as_float(((unsigned)b) << 16); }
__device__ __forceinline__ float bflo(unsigned w) { return __uint_as_float(w << 16); }
__device__ __forceinline__ float bfhi(unsigned w) { return __uint_as_float(w & 0xffff0000u); }
__device__ __forceinline__ float sigmoidf_(float v) { return __builtin_amdgcn_rcpf(1.0f + __expf(-v)); }
#define LDS_WAIT() asm volatile("s_waitcnt lgkmcnt(0)" ::: "memory")
__device__ __forceinline__ int opaque_tid() { int t = threadIdx.x; asm volatile("" : "+v"(t)); return t; }

namespace pg8 {
constexpr int BM = 256, BK = 64, HALF = 128, HTB = HALF * BK * 2, STAGE_BYTES = 8 * HTB, NXCD = 8, WGM = 8;
__host__ __device__ __forceinline__ int lds_byte(int r, int c) { const int st = (r >> 4) * 2 + (c >> 5), rr = r & 15, cc = c & 31, ob = rr * 64 + cc * 2; return st * 1024 + (ob ^ (((ob >> 9) & 1) << 5)); }
__host__ __device__ __forceinline__ void stage_rc(int b, int& R, int& C) { const int st = b / 1024, sb = b % 1024, swz = sb ^ (((sb >> 9) & 1) << 5); R = (st >> 1) * 16 + swz / 64; C = (st & 1) * 32 + (swz % 64) / 2; }
__host__ __device__ __forceinline__ int perm32(int rho) { const int n = rho >> 4, i = rho & 15; return 8 * (i >> 2) + 4 * n + (i & 3); }

struct Unit { int pm, pn, br; };
struct Gemm { const bf16_t* A; const bf16_t* Bt; int M, N, K; size_t sA, sB; };

struct StaticOrder {
    int nM, nN, nwg, G, c;
    __device__ void init(int M, int N, int G_, int c_) { nM = M / BM; nN = N / BM; nwg = nM * nN; G = G_; c = c_; }
    __device__ __forceinline__ bool next(int i, Unit& u) const {
        const long L = (long)i * G + c; if (L >= nwg) return false;
        int wgid = (int)L; { const int q = nwg / NXCD, r = nwg % NXCD, xcd = wgid % NXCD, off = wgid / NXCD; wgid = (xcd < r ? xcd * (q + 1) : r * (q + 1) + (xcd - r) * q) + off; }
        const int nig = WGM * nN, gid = wgid / nig, fm = gid * WGM, gsz = (nM - fm) < WGM ? (nM - fm) : WGM;
        u.pm = fm + ((wgid % nig) % gsz); u.pn = (wgid % nig) / gsz; u.br = 0; return true;
    }
};
struct Order3 : StaticOrder {
    __device__ __forceinline__ bool next(int i, Unit& u) const { if (!StaticOrder::next(i / 3, u)) return false; u.br = i % 3; return true; }
};

template <class Epi, class Sched>
__device__ __forceinline__ void gemm_phase(LAS unsigned char* lds, const Gemm g, const Sched& S, const Epi& E) {
    const int tid = opaque_tid(), wid = __builtin_amdgcn_readfirstlane(tid >> 6), lane = tid & 63, wr = wid >> 2, wc = wid & 3, fr = lane & 15, fq = lane >> 4;
    const int K = g.K, nt = K / BK;
    unsigned voffA[2], voffB[2];
#pragma unroll
    for (int i = 0; i < 2; ++i) { int R, C; stage_rc(tid * 16 + i * 8192, R, C); const int Rb = (R & ~31) + perm32(R & 31);
        voffA[i] = (unsigned)(R * K + C) * 2u; voffB[i] = (unsigned)(Rb * K + C) * 2u; }
    const size_t kstep = (size_t)(BK * 2);
    const size_t hstep = (size_t)HALF * K * 2;
    const size_t tstep = 2 * hstep;
    const unsigned ldsw = (unsigned)wid * 1024u;
    const int aoff = lds_byte(wr * 64 + fr, fq * 8), boff = lds_byte(wc * 32 + fr, fq * 8);
#define PG8_SA(b, h) (((b) * 2 + (h)) * HTB)
#define PG8_SB(b, h) ((4 + (b) * 2 + (h)) * HTB)
#define PG8_STAGE(bufoff, gbase, voff) do { _Pragma("unroll") for (int _i = 0; _i < 2; ++_i) \
        __builtin_amdgcn_global_load_lds((const unsigned*)((const char*)(gbase) + (voff)[_i]), (LAS unsigned*)(lds + (bufoff) + ldsw + _i * 8192), 16, 0, 0); } while (0)
#define PG8_LDA(dst, b, h) do { _Pragma("unroll") for (int m = 0; m < 4; ++m) _Pragma("unroll") for (int k = 0; k < 2; ++k) dst[m][k] = *(const LAS bf16x8*)(lds + PG8_SA(b, h) + aoff + m * 2048 + k * 1024); } while (0)
#define PG8_LDB(dst, b, h) do { _Pragma("unroll") for (int n = 0; n < 2; ++n) _Pragma("unroll") for (int k = 0; k < 2; ++k) dst[n][k] = *(const LAS bf16x8*)(lds + PG8_SB(b, h) + boff + n * 2048 + k * 1024); } while (0)
#define PG8_MMA(ai, bj, At, Bt) do { __builtin_amdgcn_s_setprio(1); _Pragma("unroll") for (int m = 0; m < 4; ++m) _Pragma("unroll") for (int n = 0; n < 2; ++n) _Pragma("unroll") for (int k = 0; k < 2; ++k) \
        acc[ai][bj][m][n] = __builtin_amdgcn_mfma_f32_16x16x32_bf16(Bt[n][k], At[m][k], acc[ai][bj][m][n], 0, 0, 0); __builtin_amdgcn_s_setprio(0); } while (0)
#define PG8_WAIT_V(n) asm volatile("s_waitcnt vmcnt(" #n ")" ::: "memory")
#define PG8_WAIT_L(n) asm volatile("s_waitcnt lgkmcnt(" #n ")" ::: "memory")
#define PG8_BAR __builtin_amdgcn_s_barrier()
#define PG8_SCHED __builtin_amdgcn_sched_barrier(0)
    Unit cur, nxt; int ui = 0;
    if (!S.next(0, cur)) return;
    f32x4 acc[2][2][4][2];
#pragma unroll
    for (int a = 0; a < 2; ++a)
#pragma unroll
        for (int b = 0; b < 2; ++b)
#pragma unroll
            for (int m = 0; m < 4; ++m)
#pragma unroll
                for (int n = 0; n < 2; ++n) acc[a][b][m][n] = (f32x4){0.f, 0.f, 0.f, 0.f};
    bf16x8 At[4][2], B0[2][2], B1[2][2];
    const char* cA = (const char*)g.A + (size_t)cur.br * g.sA + (size_t)cur.pm * tstep; const char* cB = (const char*)g.Bt + (size_t)cur.br * g.sB + (size_t)cur.pn * tstep;
    PG8_STAGE(PG8_SB(0, 0), cB, voffB); PG8_STAGE(PG8_SB(0, 1), cB + hstep, voffB); PG8_STAGE(PG8_SA(0, 0), cA, voffA); PG8_STAGE(PG8_SA(0, 1), cA + hstep, voffA);
    if (wr == 1) PG8_BAR;
    PG8_WAIT_V(2); PG8_BAR;
    PG8_STAGE(PG8_SB(1, 0), cB + kstep, voffB); PG8_STAGE(PG8_SA(1, 0), cA + kstep, voffA); PG8_STAGE(PG8_SB(1, 1), cB + hstep + kstep, voffB);
    PG8_WAIT_V(6); PG8_BAR;
    for (;;) {
        const bool has_next = S.next(ui + 1, nxt);
        const char* nA = has_next ? (const char*)g.A + (size_t)nxt.br * g.sA + (size_t)nxt.pm * tstep : cA; const char* nB = has_next ? (const char*)g.Bt + (size_t)nxt.br * g.sB + (size_t)nxt.pn * tstep : cB;
        for (int t = 0; t < nt; t += 2) {
            const bool last = (t == nt - 2);
            const char* a1 = cA + (size_t)(t + 1) * kstep;
            const char* a2 = last ? nA : cA + (size_t)(t + 2) * kstep; const char* b2 = last ? nB : cB + (size_t)(t + 2) * kstep;
            const char* a3 = a2 + kstep; const char* b3 = b2 + kstep;
            PG8_LDB(B0, 0, 0); PG8_LDB(B1, 0, 1); PG8_SCHED; PG8_LDA(At, 0, 0); PG8_STAGE(PG8_SA(1, 1), a1 + hstep, voffA);
            PG8_WAIT_V(8); PG8_WAIT_L(0); PG8_BAR; PG8_MMA(0, 0, At, B0); PG8_MMA(0, 1, At, B1); PG8_BAR; PG8_SCHED;
            PG8_LDA(At, 0, 1); PG8_STAGE(PG8_SB(0, 0), b2, voffB); PG8_STAGE(PG8_SB(0, 1), b2 + hstep, voffB); PG8_STAGE(PG8_SA(0, 0), a2, voffA);
            PG8_WAIT_V(8); PG8_WAIT_L(0); PG8_BAR; PG8_MMA(1, 0, At, B0); PG8_MMA(1, 1, At, B1); PG8_BAR; PG8_SCHED;
            PG8_LDB(B0, 1, 0); PG8_LDB(B1, 1, 1); PG8_SCHED; PG8_LDA(At, 1, 0); PG8_STAGE(PG8_SA(0, 1), a2 + hstep, voffA);
            PG8_WAIT_V(8); PG8_WAIT_L(0); PG8_BAR; PG8_MMA(0, 0, At, B0); PG8_MMA(0, 1, At, B1); PG8_BAR; PG8_SCHED;
            PG8_LDA(At, 1, 1); PG8_STAGE(PG8_SB(1, 0), b3, voffB); PG8_STAGE(PG8_SB(1, 1), b3 + hstep, voffB); PG8_STAGE(PG8_SA(1, 0), a3, voffA);
            PG8_WAIT_V(8); PG8_WAIT_L(0); PG8_BAR; PG8_MMA(1, 0, At, B0); PG8_MMA(1, 1, At, B1); PG8_BAR; PG8_SCHED;
        }
        if (wr == 0) PG8_BAR;
        const bool reset = E(acc, cur, wr, wc, fr, fq);
        if (!has_next) break;
        if (reset) {
#pragma unroll
            for (int a = 0; a < 2; ++a)
#pragma unroll
                for (int b = 0; b < 2; ++b)
#pragma unroll
                    for (int m = 0; m < 4; ++m)
#pragma unroll
                        for (int n = 0; n < 2; ++n) acc[a][b][m][n] = (f32x4){0.f, 0.f, 0.f, 0.f};
        }
        cur = nxt; cA = nA; cB = nB; ++ui;
        if (wr == 1) PG8_BAR;
    }
    PG8_WAIT_V(0);
    PG8_BAR;
#undef PG8_SA
#undef PG8_SB
#undef PG8_STAGE
#undef PG8_LDA
#undef PG8_LDB
#undef PG8_MMA
#undef PG8_WAIT_V
#undef PG8_WAIT_L
#undef PG8_BAR
#undef PG8_SCHED
}
}
using pg8::Unit;

struct EpiZ {
    bf16_t* Z; const u64* ssq; const float* lbs;
    __device__ __forceinline__ bool operator()(f32x4 (&acc)[2][2][4][2], const Unit& u, int wr, int wc, int fr, int fq) const {
        const int seg = u.pn < 32 ? (u.pn >> 2) : 8;
        const int mode = (seg == 8) ? 2 : (seg == 5 ? 3 : ((seg == 1 || seg == 3 || seg == 4 || seg == 7) ? 1 : 0));
        const int zadd = seg >= 6 ? 1024 : 0;
        float rs[2][4];
#pragma unroll
        for (int ai = 0; ai < 2; ++ai)
#pragma unroll
            for (int m = 0; m < 4; ++m) rs[ai][m] = ssq_rstd(ssq + u.pm * 256 + ai * 128 + wr * 64 + m * 16 + fr);
        f32x4 lbv[2][2];
#pragma unroll
        for (int bj = 0; bj < 2; ++bj) {
            const int cl = (mode == 3) ? (u.pn * 256 + bj * 128 + wc * 32 + 8 * fq - 5120) : 0;
            lbv[bj][0] = *(const f32x4*)(lbs + cl); lbv[bj][1] = *(const f32x4*)(lbs + cl + 4);
        }
#pragma unroll
        for (int ai = 0; ai < 2; ++ai)
#pragma unroll
            for (int m = 0; m < 4; ++m) {
                const int row = u.pm * 256 + ai * 128 + wr * 64 + m * 16 + fr;
#pragma unroll
                for (int bj = 0; bj < 2; ++bj) {
                    const int c = u.pn * 256 + bj * 128 + wc * 32 + 8 * fq;
                    float v[8];
#pragma unroll
                    for (int j = 0; j < 4; ++j) { v[j] = acc[ai][bj][m][0][j] * rs[ai][m]; v[4 + j] = acc[ai][bj][m][1][j] * rs[ai][m]; }
                    bf16_t* zp = Z + (size_t)row * ZW + c + zadd;
                    if (mode == 3) {
                        float gl[8], kk[8];
#pragma unroll
                        for (int j = 0; j < 8; ++j) {
                            const float lb = j < 4 ? lbv[bj][0][j] : lbv[bj][1][j - 4];
                            const float e = __expf(-v[j]); const float sg = __builtin_amdgcn_rcpf(1.0f + e);
                            const float f = lb + (1.0f - lb) * sg;
                            gl[j] = __logf(f); kk[j] = (1.0f - lb) * (e * sg);
                        }
                        u32x4 w0, w1;
                        w0.x = pk2(gl[0], gl[1]); w0.y = pk2(gl[2], gl[3]); w0.z = pk2(gl[4], gl[5]); w0.w = pk2(gl[6], gl[7]);
                        w1.x = pk2(kk[0], kk[1]); w1.y = pk2(kk[2], kk[3]); w1.z = pk2(kk[4], kk[5]); w1.w = pk2(kk[6], kk[7]);
                        *(u32x4*)zp = w0; *(u32x4*)(zp + 1024) = w1;
                    } else {
                        float o[8];
                        if (mode == 0) {
#pragma unroll
                            for (int j = 0; j < 8; ++j) o[j] = v[j];
                        } else if (mode == 1) {
#pragma unroll
                            for (int j = 0; j < 8; ++j) o[j] = v[j] * __builtin_amdgcn_rcpf(1.0f + __expf(-v[j]));
                        } else {
#pragma unroll
                            for (int j = 0; j < 8; ++j) o[j] = __builtin_amdgcn_rcpf(1.0f + __expf(-v[j]));
                        }
                        u32x4 w0; w0.x = pk2t(o[0], o[1]); w0.y = pk2t(o[2], o[3]); w0.z = pk2t(o[4], o[5]); w0.w = pk2t(o[6], o[7]);
                        *(u32x4*)zp = w0;
                    }
                }
            }
        return true;
    }
};
struct EpiGlu {
    const bf16_t* Ypre; const bf16_t* Z; const float* bglu; bf16_t* Ya;
    __device__ __forceinline__ bool operator()(f32x4 (&acc)[2][2][4][2], const Unit& u, int wr, int wc, int fr, int fq) const {
        f32x4 bv[2][2];
#pragma unroll
        for (int bj = 0; bj < 2; ++bj) { const int c = u.pn * 256 + bj * 128 + wc * 32 + 8 * fq; bv[bj][0] = *(const f32x4*)(bglu + c); bv[bj][1] = *(const f32x4*)(bglu + c + 4); }
#pragma unroll
        for (int ai = 0; ai < 2; ++ai) {
            u32x4 yp[4][2], sg[4][2];
#pragma unroll
            for (int m = 0; m < 4; ++m)
#pragma unroll
                for (int bj = 0; bj < 2; ++bj) {
                    const int row = u.pm * 256 + ai * 128 + wr * 64 + m * 16 + fr, c = u.pn * 256 + bj * 128 + wc * 32 + 8 * fq;
                    yp[m][bj] = *(const u32x4*)(Ypre + (size_t)row * WM + c); sg[m][bj] = *(const u32x4*)(Z + (size_t)row * ZW + 1024 + c);
                }
            __builtin_amdgcn_sched_barrier(0);
#pragma unroll
            for (int m = 0; m < 4; ++m)
#pragma unroll
                for (int bj = 0; bj < 2; ++bj) {
                    const int row = u.pm * 256 + ai * 128 + wr * 64 + m * 16 + fr, c = u.pn * 256 + bj * 128 + wc * 32 + 8 * fq;
                    float o[8];
#pragma unroll
                    for (int j = 0; j < 8; ++j) {
                        const float a = (j < 4 ? acc[ai][bj][m][0][j] : acc[ai][bj][m][1][j - 4]) + (j < 4 ? bv[bj][0][j] : bv[bj][1][j - 4]);
                        const unsigned ypw = yp[m][bj][j >> 1], sgw = sg[m][bj][j >> 1];
                        const float y = (j & 1) ? bfhi(ypw) : bflo(ypw), s = (j & 1) ? bfhi(sgw) : bflo(sgw);
                        o[j] = y * sigmoidf_(a) * s;
                    }
                    u32x4 w0; w0.x = pk2(o[0], o[1]); w0.y = pk2(o[2], o[3]); w0.z = pk2(o[4], o[5]); w0.w = pk2(o[6], o[7]);
                    *(u32x4*)(Ya + (size_t)row * WM + c) = w0;
                }
            __builtin_amdgcn_sched_barrier(0);
        }
        return true;
    }
};
struct EpiBr {
    const bf16_t* Z; bf16_t* Mrg;
    __device__ __forceinline__ bool operator()(f32x4 (&acc)[2][2][4][2], const Unit& u, int wr, int wc, int fr, int fq) const {
        const int br = u.br, nb = br < 2 ? br + 1 : br;
#pragma unroll
        for (int ai = 0; ai < 2; ++ai) {
            u32x4 ga[4][2], gb[4][2];
#pragma unroll
            for (int m = 0; m < 4; ++m)
#pragma unroll
                for (int bj = 0; bj < 2; ++bj) {
                    const int row = u.pm * 256 + ai * 128 + wr * 64 + m * 16 + fr, c = u.pn * 256 + bj * 128 + wc * 32 + 8 * fq;
                    const bf16_t* gp = Z + (size_t)row * ZW + 9216 + c;
                    ga[m][bj] = *(const u32x4*)(gp + br * 2048); gb[m][bj] = *(const u32x4*)(gp + nb * 2048);
                }
            __builtin_amdgcn_sched_barrier(0);
#pragma unroll
            for (int m = 0; m < 4; ++m)
#pragma unroll
                for (int bj = 0; bj < 2; ++bj) {
                    const int row = u.pm * 256 + ai * 128 + wr * 64 + m * 16 + fr, c = u.pn * 256 + bj * 128 + wc * 32 + 8 * fq;
                    if (br < 2) {
#pragma unroll
                        for (int j = 0; j < 8; ++j) {
                            const unsigned aw = ga[m][bj][j >> 1], bw = gb[m][bj][j >> 1];
                            const float x = (j & 1) ? bfhi(aw) : bflo(aw), y = (j & 1) ? bfhi(bw) : bflo(bw);
                            const float r = x * __builtin_amdgcn_rcpf(fmaxf(y, 1e-30f));
                            if (j < 4) acc[ai][bj][m][0][j] *= r; else acc[ai][bj][m][1][j - 4] *= r;
                        }
                    } else {
                        float o[8];
#pragma unroll
                        for (int j = 0; j < 8; ++j) {
                            const unsigned aw = ga[m][bj][j >> 1];
                            const float x = (j & 1) ? bfhi(aw) : bflo(aw);
                            o[j] = (j < 4 ? acc[ai][bj][m][0][j] : acc[ai][bj][m][1][j - 4]) * x;
                        }
                        u32x4 w0; w0.x = pk2(o[0], o[1]); w0.y = pk2(o[2], o[3]); w0.z = pk2(o[4], o[5]); w0.w = pk2(o[6], o[7]);
                        *(u32x4*)(Mrg + (size_t)row * DM + c) = w0;
                    }
                }
            __builtin_amdgcn_sched_barrier(0);
        }
        return br == 2;
    }
};
struct EpiOut {
    const float* Xin; bf16_t* Xb; u64* ssq;
    __device__ __forceinline__ bool operator()(f32x4 (&acc)[2][2][4][2], const Unit& u, int wr, int wc, int fr, int fq) const {
        const bool first = Xin != nullptr;
#pragma unroll
        for (int ai = 0; ai < 2; ++ai) {
            if (first) {
                f32x4 xi[4][2][2];
#pragma unroll
                for (int m = 0; m < 4; ++m)
#pragma unroll
                    for (int bj = 0; bj < 2; ++bj) {
                        const int row = u.pm * 256 + ai * 128 + wr * 64 + m * 16 + fr, c = u.pn * 256 + bj * 128 + wc * 32 + 8 * fq;
                        xi[m][bj][0] = *(const f32x4*)(Xin + (size_t)row * DM + c); xi[m][bj][1] = *(const f32x4*)(Xin + (size_t)row * DM + c + 4);
                    }
                __builtin_amdgcn_sched_barrier(0);
#pragma unroll
                for (int m = 0; m < 4; ++m)
#pragma unroll
                    for (int bj = 0; bj < 2; ++bj) { acc[ai][bj][m][0] += xi[m][bj][0]; acc[ai][bj][m][1] += xi[m][bj][1]; }
            } else {
                u32x4 xw[4][2];
#pragma unroll
                for (int m = 0; m < 4; ++m)
#pragma unroll
                    for (int bj = 0; bj < 2; ++bj) {
                        const int row = u.pm * 256 + ai * 128 + wr * 64 + m * 16 + fr, c = u.pn * 256 + bj * 128 + wc * 32 + 8 * fq;
                        xw[m][bj] = *(const u32x4*)(Xb + (size_t)row * DM + c);
                    }
                __builtin_amdgcn_sched_barrier(0);
#pragma unroll
                for (int m = 0; m < 4; ++m)
#pragma unroll
                    for (int bj = 0; bj < 2; ++bj) {
                        const u32x4 w = xw[m][bj];
                        acc[ai][bj][m][0] += (f32x4){bflo(w.x), bfhi(w.x), bflo(w.y), bfhi(w.y)}; acc[ai][bj][m][1] += (f32x4){bflo(w.z), bfhi(w.z), bflo(w.w), bfhi(w.w)};
                    }
            }
#pragma unroll
            for (int m = 0; m < 4; ++m) {
                const int row = u.pm * 256 + ai * 128 + wr * 64 + m * 16 + fr;
                float part = 0.f;
#pragma unroll
                for (int bj = 0; bj < 2; ++bj) {
                    const int c = u.pn * 256 + bj * 128 + wc * 32 + 8 * fq;
                    const f32x4 v0 = acc[ai][bj][m][0], v1 = acc[ai][bj][m][1];
                    u32x4 w0; w0.x = pk2(v0[0], v0[1]); w0.y = pk2(v0[2], v0[3]); w0.z = pk2(v1[0], v1[1]); w0.w = pk2(v1[2], v1[3]);
                    *(u32x4*)(Xb + (size_t)row * DM + c) = w0;
                    part += v0[0] * v0[0] + v0[1] * v0[1] + v0[2] * v0[2] + v0[3] * v0[3] + v1[0] * v1[0] + v1[1] * v1[1] + v1[2] * v1[2] + v1[3] * v1[3];
                }
                part += __shfl_xor(part, 16); part += __shfl_xor(part, 32);
                if (fq == 0) atomicAdd(ssq + row, (u64)(part * 16777216.0f));
            }
            __builtin_amdgcn_sched_barrier(0);
        }
        return true;
    }
};

__device__ __forceinline__ void mma32(f32x16& acc, const LAS bf16_t* A, int lda, const LAS bf16_t* Bt, int ldb, int K, int lane) {
    const int r = lane & 31, h = lane >> 5;
    const LAS bf16_t* pa = A + r * lda + 8 * h; const LAS bf16_t* pb = Bt + r * ldb + 8 * h;
    for (int k = 0; k < K; k += 16) {
        const bf16x8 a = *(const LAS bf16x8*)(pa + k); const bf16x8 b = *(const LAS bf16x8*)(pb + k);
        acc = __builtin_amdgcn_mfma_f32_32x32x16_bf16(a, b, acc, 0, 0, 0);
    }
}
__device__ __forceinline__ int row32(int reg, int lane) { return (reg & 3) + 8 * (reg >> 2) + 4 * (lane >> 5); }

__device__ __forceinline__ void transpose_item(const float* W, int K, int N, bf16_t* WT, const float* scale, LAS float* scr, int item, int lane) {
    const int nkb = K / 64, kb = item % nkb, nb = item / nkb, k0 = 64 * kb, n0 = 64 * nb;
    const int r = lane >> 4, c4 = lane & 15;
    f32x4 vv[16];
#pragma unroll
    for (int i = 0; i < 16; ++i) vv[i] = __builtin_nontemporal_load((const f32x4*)(W + (size_t)(k0 + 4 * i + r) * N + n0 + 4 * c4));
    if (scale) {
#pragma unroll
        for (int i = 0; i < 16; ++i) vv[i] = vv[i] * scale[k0 + 4 * i + r];
    }
#pragma unroll
    for (int i = 0; i < 16; ++i) {
        LAS float* d = scr + (4 * i + r) * 65 + 4 * c4;
        d[0] = vv[i][0]; d[1] = vv[i][1]; d[2] = vv[i][2]; d[3] = vv[i][3];
    }
    LDS_WAIT();
    const int cch = lane & 7;
#pragma unroll
    for (int j = 0; j < 8; ++j) { const int n = (lane >> 3) + 8 * j; const LAS float* s = scr + (8 * cch) * 65 + n;
        u32x4 o; o.x = pk2(s[0], s[65]); o.y = pk2(s[2 * 65], s[3 * 65]); o.z = pk2(s[4 * 65], s[5 * 65]); o.w = pk2(s[6 * 65], s[7 * 65]);
        *(u32x4*)(WT + (size_t)(n0 + n) * K + k0 + 8 * cch) = o; }
    LDS_WAIT();
}

struct Args { const float* in[25]; float* out; unsigned char* ws; };

__device__ __forceinline__ void phase_prep(const Args& a, LAS unsigned char* lds) {
    const int tid = opaque_tid(), lane = tid & 63, wave = tid >> 6;
    unsigned char* ws = a.ws;
    {
        LAS float* scr = (LAS float*)(lds + wave * 16640);
        const int gw = blockIdx.x * 8 + wave, NGW = gridDim.x * 8;
        constexpr int I_IN = 32 * 224, I_GLU = 16 * 16, I_BR = 16 * 32, I_OUT = 32 * 32, I_L = I_IN + I_GLU + 3 * I_BR + I_OUT;
        for (int it = gw; it < DEPTH * I_L; it += NGW) {
            const int l = it / I_L; int r = it % I_L;
            if (r < I_IN) { transpose_item(a.in[2] + (size_t)l * DM * NIN, DM, NIN, (bf16_t*)(ws + OFF_WIN) + (size_t)l * NIN * DM, a.in[1] + l * DM, scr, r, lane); continue; } r -= I_IN;
            if (r < I_GLU) { transpose_item(a.in[11] + (size_t)l * WM * WM, WM, WM, (bf16_t*)(ws + OFF_WGLU) + (size_t)l * WM * WM, nullptr, scr, r, lane); continue; } r -= I_GLU;
            if (r < 3 * I_BR) { const int br = r / I_BR; r %= I_BR;
                transpose_item(a.in[22] + ((size_t)l * 3 + br) * WM * DM, WM, DM, (bf16_t*)(ws + OFF_WBR) + ((size_t)l * 3 + br) * DM * WM, nullptr, scr, r, lane); continue; } r -= 3 * I_BR;
            transpose_item(a.in[23] + (size_t)l * DM * DM, DM, DM, (bf16_t*)(ws + OFF_WOUT) + (size_t)l * DM * DM, nullptr, scr, r, lane);
        }
    }
    {
        const float* x = a.in[0]; bf16_t* xb = (bf16_t*)(ws + OFF_XB); u64* ssq = (u64*)(ws + OFF_SSQ);
        for (int row = blockIdx.x * 8 + wave; row < T_TOK; row += gridDim.x * 8) {
            float s = 0.f;
#pragma unroll
            for (int j = 0; j < 8; ++j) {
                const f32x4 v = *(const f32x4*)(x + (size_t)row * DM + 4 * lane + 256 * j);
                s += v[0] * v[0] + v[1] * v[1] + v[2] * v[2] + v[3] * v[3];
                u32x2 w; w.x = pk2(v[0], v[1]); w.y = pk2(v[2], v[3]);
                *(u32x2*)(xb + (size_t)row * DM + 4 * lane + 256 * j) = w;
            }
#pragma unroll
            for (int o = 1; o < 64; o <<= 1) s += __shfl_xor(s, o);
            if (lane == 0) ssq[row] = (u64)(s * 16777216.0f);
        }
    }
    const int gt = blockIdx.x * 512 + tid, NT = gridDim.x * 512;
    { u64* ssq = (u64*)(ws + OFF_SSQ) + T_TOK; for (int i = gt; i < 4 * T_TOK; i += NT) ssq[i] = 0ull; }
    for (int i = gt; i < WM; i += NT) {
        const float* hb = a.in[20]; const float v0 = hb[i], v1 = hb[WM + i], v2 = hb[2 * WM + i], v3 = hb[3 * WM + i];
        const float mx = fmaxf(fmaxf(v0, v1), fmaxf(v2, v3));
        const float e0 = expf(v0 - mx), e1 = expf(v1 - mx), e2 = expf(v2 - mx), e3 = expf(v3 - mx), inv = 1.0f / (e0 + e1 + e2 + e3);
        float* lbs = (float*)(ws + OFF_LBS);
        lbs[i] = 0.f; lbs[WM + i] = e1 * inv; lbs[2 * WM + i] = (e1 + e2) * inv; lbs[3 * WM + i] = (e1 + e2 + e3) * inv;
    }
    for (int i = gt; i < DEPTH * 64 * 64; i += NT) {
        const int l = i >> 12, g = (i >> 6) & 63, p = i & 63;
        const float lre = a.in[3][i], lim = a.in[4][i], step = expf(a.in[5][l * 64 + g]);
        const float mag = expf(lre * step), ang = lim * step;
        const float are = mag * cosf(ang), aim = mag * sinf(ang);
        const float nre = are - 1.0f, nim = aim, den = lre * lre + lim * lim;
        const float cre = (nre * lre + nim * lim) / den, cim = (nim * lre - nre * lim) / den;
        ((float2*)(ws + OFF_S5A))[i] = make_float2(are, aim);
        const float* bre = a.in[6] + (size_t)i * 16; const float* bim = a.in[7] + (size_t)i * 16;
        bf16_t* bt = (bf16_t*)(ws + OFF_S5BT) + ((size_t)(l * 64 + g) * 128) * 16;
        bf16_t* ct = (bf16_t*)(ws + OFF_S5CT) + ((size_t)(l * 64 + g) * 16) * 128;
        const float* cr = a.in[8] + (size_t)(l * 64 + g) * 16 * 64; const float* ci = a.in[9] + (size_t)(l * 64 + g) * 16 * 64;
#pragma unroll 4
        for (int h = 0; h < 16; ++h) {
            const float br_ = bre[h], bi_ = bim[h];
            bt[(size_t)(2 * p) * 16 + h] = f2bf(cre * br_ - cim * bi_);
            bt[(size_t)(2 * p + 1) * 16 + h] = f2bf(cre * bi_ + cim * br_);
            ct[(size_t)h * 128 + 2 * p] = f2bf(cr[h * 64 + p]);
            ct[(size_t)h * 128 + 2 * p + 1] = f2bf(-ci[h * 64 + p]);
        }
    }
    for (int i = gt; i < DEPTH * 16 * 128 * 64; i += NT) {
        const int ii = i & 63, j = (i >> 6) & 127, ln = i >> 13;
        const float v = j < 64 ? a.in[15][(size_t)ln * 4096 + ii * 64 + j] : a.in[17][(size_t)ln * 4096 + ii * 64 + (j - 64)];
        ((bf16_t*)(ws + OFF_RGW))[i] = f2bf(v);
    }
}

__device__ __forceinline__ void s5_item(LAS unsigned char* lds, const bf16_t* Z, bf16_t* Ypre, const float2* abar, const bf16_t* BT, const bf16_t* CT, const float* dvec, int b, int g) {
    const int tid = opaque_tid(), lane = tid & 63, w = __builtin_amdgcn_readfirstlane(tid >> 6);
    const int r = lane & 31, h = lane >> 5;
    const size_t Rb = (size_t)b * SEQ;
    if (w >= 4) {
        const int nt = w - 4;
        const bf16x8 bfrag = *(const bf16x8*)(BT + (size_t)(32 * nt + r) * 16 + 8 * h);
        const bf16_t* zA = Z + (Rb + r) * ZW + g * 16 + 8 * h;
        bf16x8 a0n = *(const bf16x8*)zA, a1n = *(const bf16x8*)(zA + (size_t)32 * ZW);
#pragma unroll 1
        for (int it = 0; it < 66; ++it) {
            if (it < 64) {
                const bf16x8 a0 = a0n, a1 = a1n;
                if (it + 1 < 64) { a0n = *(const bf16x8*)(zA + (size_t)(64 * (it + 1)) * ZW); a1n = *(const bf16x8*)(zA + (size_t)(64 * (it + 1) + 32) * ZW); }
                LAS float* BU = (LAS float*)(lds + (it & 1) * 32768);
                f32x16 acc;
#pragma unroll
                for (int i = 0; i < 16; ++i) acc[i] = 0.f;
                acc = __builtin_amdgcn_mfma_f32_32x32x16_bf16(a0, bfrag, acc, 0, 0, 0);
#pragma unroll
                for (int reg = 0; reg < 16; ++reg) BU[row32(reg, lane) * 128 + 32 * nt + r] = acc[reg];
#pragma unroll
                for (int i = 0; i < 16; ++i) acc[i] = 0.f;
                acc = __builtin_amdgcn_mfma_f32_32x32x16_bf16(a1, bfrag, acc, 0, 0, 0);
#pragma unroll
                for (int reg = 0; reg < 16; ++reg) BU[(32 + row32(reg, lane)) * 128 + 32 * nt + r] = acc[reg];
            }
            __syncthreads();
        }
    } else if (w == 0) {
        const float2 ab = abar[lane];
        float xr = 0.f, xi = 0.f;
        __builtin_amdgcn_s_setprio(3);
#pragma unroll 1
        for (int it = 0; it < 66; ++it) {
            if (it >= 1 && it <= 64) {
                const LAS float* BU = (const LAS float*)(lds + ((it - 1) & 1) * 32768);
                LAS bf16_t* XS = (LAS bf16_t*)(lds + 65536 + ((it - 1) & 1) * 17408);
                f32x2 bb[2][16];
#pragma unroll
                for (int i = 0; i < 16; ++i) bb[0][i] = *(const LAS f32x2*)(BU + i * 128 + 2 * lane);
#pragma unroll
                for (int tb = 0; tb < 4; ++tb) {
                    if (tb < 3) {
#pragma unroll
                        for (int i = 0; i < 16; ++i) bb[(tb + 1) & 1][i] = *(const LAS f32x2*)(BU + (16 * (tb + 1) + i) * 128 + 2 * lane);
                    }
#pragma unroll
                    for (int i = 0; i < 16; ++i) {
                        const f32x2 bv = bb[tb & 1][i];
                        float t1 = __builtin_fmaf(-ab.y, xi, bv.x), t2 = __builtin_fmaf(ab.y, xr, bv.y);
                        asm("" : "+v"(t1)); asm("" : "+v"(t2));
                        const float nr = __builtin_fmaf(ab.x, xr, t1), ni = __builtin_fmaf(ab.x, xi, t2);
                        xr = nr; xi = ni;
                        *(LAS unsigned*)(XS + (16 * tb + i) * 136 + 2 * lane) = pk2(xr, xi);
                    }
                }
            }
            __syncthreads();
        }
        __builtin_amdgcn_s_setprio(0);
    } else {
        const int nty = w == 1 ? 2 : 1, ty0 = w == 1 ? 0 : w;
        bf16x8 cfrag[4];
#pragma unroll
        for (int ks = 0; ks < 4; ++ks) cfrag[ks] = *(const bf16x8*)(CT + (size_t)(lane & 15) * 128 + 32 * ks + 8 * (lane >> 4));
        const float dd = dvec[g * 16 + (lane & 15)];
        const bf16_t* zU = Z + (Rb + (lane >> 4) * 4) * ZW + g * 16 + (lane & 15);
        bf16_t un[2][4];
#pragma unroll
        for (int q = 0; q < 2; ++q)
#pragma unroll
            for (int reg = 0; reg < 4; ++reg) un[q][reg] = (q < nty) ? zU[(size_t)(16 * (ty0 + q) + reg) * ZW] : (bf16_t)0;
#pragma unroll 1
        for (int it = 0; it < 66; ++it) {
            if (it >= 2) {
                const int c = it - 2;
                const LAS bf16_t* XS = (const LAS bf16_t*)(lds + 65536 + (c & 1) * 17408);
                bf16_t uc[2][4];
#pragma unroll
                for (int q = 0; q < 2; ++q)
#pragma unroll
                    for (int reg = 0; reg < 4; ++reg) uc[q][reg] = un[q][reg];
                if (c + 1 < 64) {
#pragma unroll
                    for (int q = 0; q < 2; ++q)
#pragma unroll
                        for (int reg = 0; reg < 4; ++reg) if (q < nty) un[q][reg] = zU[(size_t)(64 * (c + 1) + 16 * (ty0 + q) + reg) * ZW];
                }
#pragma unroll
                for (int q = 0; q < 2; ++q) {
                    if (q < nty) {
                        const int ty = ty0 + q;
                        f32x4 a4 = (f32x4){0.f, 0.f, 0.f, 0.f};
#pragma unroll
                        for (int ks = 0; ks < 4; ++ks) {
                            const bf16x8 av = *(const LAS bf16x8*)(XS + (16 * ty + (lane & 15)) * 136 + 32 * ks + 8 * (lane >> 4));
                            a4 = __builtin_amdgcn_mfma_f32_16x16x32_bf16(av, cfrag[ks], a4, 0, 0, 0);
                        }
#pragma unroll
                        for (int reg = 0; reg < 4; ++reg) {
                            const int t = 16 * ty + (lane >> 4) * 4 + reg, hh = lane & 15;
                            const float y = a4[reg] + dd * bf2f(uc[q][reg]);
                            const float uu = 0.7978845608f * (y + 0.044715f * y * y * y);
                            const float th = 1.0f - 2.0f * __builtin_amdgcn_rcpf(1.0f + __expf(2.0f * uu));
                            Ypre[(Rb + 64 * c + t) * WM + g * 16 + hh] = f2bf(0.5f * y * (1.0f + th));
                        }
                    }
                }
            }
            __syncthreads();
        }
    }
    __syncthreads();
}

__device__ __forceinline__ unsigned flag_ld(const unsigned* p) { return __hip_atomic_load(p, __ATOMIC_RELAXED, __HIP_MEMORY_SCOPE_AGENT); }
struct RgSetup { float cw0, cw1, cw2, cw3, cb, bias, sp8; bf16x8 wfrag[4]; };
__device__ __forceinline__ RgSetup rg_setup(const bf16_t* WgT, const float* convw, const float* convb, const float* b_a, const float* b_x, const float* lam, int n) {
    const int tid = opaque_tid(), lane = tid & 63, w = __builtin_amdgcn_readfirstlane(tid >> 6);
    RgSetup s; const int ch = n * 64 + lane;
    s.cw0 = convw[ch]; s.cw1 = convw[WM + ch]; s.cw2 = convw[2 * WM + ch]; s.cw3 = convw[3 * WM + ch]; s.cb = convb[ch];
    const int nt = w & 3, r = lane & 31, h = lane >> 5;
#pragma unroll
    for (int ks = 0; ks < 4; ++ks) s.wfrag[ks] = *(const bf16x8*)(WgT + (size_t)(32 * nt + r) * 64 + 16 * ks + 8 * h);
    const int chg = n * 64 + ((32 * nt + r) & 63);
    s.bias = nt < 2 ? b_a[chg] : b_x[chg];
    s.sp8 = 8.0f * log1pf(expf(-lam[chg]));
    return s;
}
__device__ __forceinline__ void rg_item(LAS unsigned char* lds, const bf16_t* Z, bf16_t* Yb, const RgSetup st, int seg, int b, int n, float* summ, unsigned* flags, unsigned want) {
    const int tid = opaque_tid(), lane = tid & 63, w = __builtin_amdgcn_readfirstlane(tid >> 6);
    LAS float* XCf = (LAS float*)lds;
    LAS bf16_t* XCb = (LAS bf16_t*)(lds + 16384);
    LAS float* A_ = (LAS float*)(lds + 25600);
    LAS float* M_ = (LAS float*)(lds + 41984);
    LAS float* IX_ = (LAS float*)(lds + 58368);
    LAS float* HL = (LAS float*)(lds + 74752);
    LAS float* AC = (LAS float*)(lds + 107520);
    LAS float* HIN = (LAS float*)(lds + 140288);
    const int c = lane, oct = w, ch = n * 64 + c;
    const float cw0 = st.cw0, cw1 = st.cw1, cw2 = st.cw2, cw3 = st.cw3, cb = st.cb;
    const int mt = w >> 2, nt = w & 3, r = lane & 31, h = lane >> 5;
    const int cc = (32 * nt + r) & 63;
    const float bias = st.bias, sp8 = st.sp8;
    float hstate = 0.f, aprod = 1.f;
    const int ts = 128 * seg;
    const bf16_t* zx = Z + ((size_t)b * SEQ + ts + 8 * oct) * ZW + 2048 + ch;
    bf16_t xn[11];
#pragma unroll
    for (int i = 0; i < 11; ++i) xn[i] = (ts + 8 * oct - 3 + i >= 0) ? zx[(ptrdiff_t)(i - 3) * ZW] : (bf16_t)0;
    bf16_t sg[16];
    {
        const bf16_t* zs = Z + ((size_t)b * SEQ + ts + 16 * w) * ZW + 3072 + ch;
#pragma unroll
        for (int i = 0; i < 16; ++i) sg[i] = zs[(size_t)i * ZW];
    }
#pragma unroll 1
    for (int tile = 0; tile < 2; ++tile) {
        const int t0 = ts + 64 * tile;
        {
            float xv[11];
#pragma unroll
            for (int i = 0; i < 11; ++i) xv[i] = bf2f(xn[i]);
            if (tile == 0) {
                const bf16_t* zn = zx + (size_t)64 * ZW;
#pragma unroll
                for (int i = 0; i < 11; ++i) xn[i] = zn[(ptrdiff_t)(i - 3) * ZW];
            }
#pragma unroll
            for (int i = 0; i < 8; ++i) {
                const float xc = cb + cw0 * xv[i] + cw1 * xv[i + 1] + cw2 * xv[i + 2] + cw3 * xv[i + 3];
                const int t = 8 * oct + i;
                XCf[t * 64 + c] = xc; XCb[t * 72 + c] = f2bf(xc);
            }
        }
        __syncthreads();
        {
            f32x16 acc;
#pragma unroll
            for (int i = 0; i < 16; ++i) acc[i] = 0.f;
#pragma unroll
            for (int ks = 0; ks < 4; ++ks) {
                const bf16x8 av = *(const LAS bf16x8*)(XCb + (32 * mt + r) * 72 + 16 * ks + 8 * h);
                acc = __builtin_amdgcn_mfma_f32_32x32x16_bf16(av, st.wfrag[ks], acc, 0, 0, 0);
            }
#pragma unroll
            for (int reg = 0; reg < 16; ++reg) {
                const int t = 32 * mt + row32(reg, lane);
                const float s = sigmoidf_(acc[reg] + bias);
                if (nt < 2) {
                    const float la = -s * sp8; const float av = __expf(la); const float x2 = 2.0f * la;
                    const float m2 = x2 > -0.05f ? -x2 * (1.0f + x2 * (0.5f + x2 * (0.16666667f + x2 * 0.041666667f))) : 1.0f - __expf(x2);
                    float mult = sqrtf(m2); if (t0 + t == 0) mult = 1.0f;
                    A_[t * 64 + cc] = av; M_[t * 64 + cc] = mult;
                } else IX_[t * 64 + cc] = s * XCf[t * 64 + cc];
            }
        }
        __syncthreads();
        if (w == 0) {
#pragma unroll 1
            for (int tb = 0; tb < 4; ++tb) {
                float a_[16], m_[16], x_[16];
#pragma unroll
                for (int i = 0; i < 16; ++i) { const int t = 16 * tb + i; a_[i] = A_[t * 64 + c]; m_[i] = M_[t * 64 + c]; x_[i] = IX_[t * 64 + c]; }
#pragma unroll
                for (int i = 0; i < 16; ++i) {
                    hstate = a_[i] * hstate + m_[i] * x_[i]; aprod *= a_[i];
                    HL[(64 * tile + 16 * tb + i) * 64 + c] = hstate; AC[(64 * tile + 16 * tb + i) * 64 + c] = aprod;
                }
            }
        }
        __syncthreads();
    }
    const int bn = b * 16 + n;
    if (w == 0) {
        float* sm = summ + ((size_t)(seg * 32 + bn)) * 128;
        __hip_atomic_store(sm + c, aprod, __ATOMIC_RELAXED, __HIP_MEMORY_SCOPE_AGENT);
        __hip_atomic_store(sm + 64 + c, hstate, __ATOMIC_RELAXED, __HIP_MEMORY_SCOPE_AGENT);
        asm volatile("s_waitcnt vmcnt(0)" ::: "memory");
        if (lane == 0) __hip_atomic_store(flags + seg * 32 + bn, want, __ATOMIC_RELAXED, __HIP_MEMORY_SCOPE_AGENT);
        float hin = 0.f;
        if (seg > 0) {
            unsigned spins = 0;
            for (;;) {
                const int ok = (lane < seg) ? (flag_ld(flags + lane * 32 + bn) >= want) : 1;
                if (__all(ok)) break;
                __builtin_amdgcn_s_sleep(2);
                if (++spins > (1u << 22)) break;
            }
#pragma unroll 1
            for (int s0 = 0; s0 < seg; s0 += 8) {
                float at[8], he[8];
#pragma unroll
                for (int q = 0; q < 8; ++q) {
                    const int s2 = (s0 + q < seg) ? s0 + q : seg - 1;
                    float* p = summ + ((size_t)(s2 * 32 + bn)) * 128;
                    at[q] = __hip_atomic_load(p + c, __ATOMIC_RELAXED, __HIP_MEMORY_SCOPE_AGENT); he[q] = __hip_atomic_load(p + 64 + c, __ATOMIC_RELAXED, __HIP_MEMORY_SCOPE_AGENT);
                }
#pragma unroll
                for (int q = 0; q < 8; ++q) if (s0 + q < seg) hin = at[q] * hin + he[q];
            }
        }
        HIN[c] = hin;
    }
    __syncthreads();
    {
        const float hin = HIN[c];
        bf16_t* yo = Yb + ((size_t)b * SEQ + ts + 16 * w) * WM + ch;
#pragma unroll
        for (int i = 0; i < 16; ++i) {
            const int t = 16 * w + i;
            yo[(size_t)i * WM] = f2bf((HL[t * 64 + c] + AC[t * 64 + c] * hin) * bf2f(sg[i]));
        }
    }
    __syncthreads();
}

__device__ __forceinline__ void hg_item(LAS unsigned char* lds, const bf16_t* Z, bf16_t* Yc, const float* normw, int b, int hd, int seg,
                                        float* OL, bf16_t* QH, float* USEG, float* DSEG, unsigned* flags, unsigned want) {
    const int tid = opaque_tid(), lane = tid & 63, w = __builtin_amdgcn_readfirstlane(tid >> 6);
    LAS float* Of = (LAS float*)lds;
    LAS bf16_t* QT = (LAS bf16_t*)(lds + 32768);
    LAS bf16_t* KT = (LAS bf16_t*)(lds + 50176);
    LAS bf16_t* KTT = (LAS bf16_t*)(lds + 67584);
    LAS bf16_t* VT = (LAS bf16_t*)(lds + 86016);
    LAS bf16_t* PP = (LAS bf16_t*)(lds + 104448);
    LAS bf16_t* ST = (LAS bf16_t*)(lds + 113664);
    LAS float* TOT = (LAS float*)(lds + 148480);
    LAS float* E1 = (LAS float*)(lds + 152576);
    LAS float* E2 = (LAS float*)(lds + 153088);
    const int t_ = tid >> 3, cg_ = (tid & 7) * 16;
    const int kp = lane;
    const int kt = w >> 1, vt0 = 2 * (w & 1);
    const int mt = w >> 2, vt = w & 3;
    const int bh = b * 8 + hd, item = seg * 16 + bh;
    const size_t Rs = (size_t)b * SEQ + 512 * seg;
    f32x16 S0, S1;
#pragma unroll
    for (int i = 0; i < 16; ++i) { S0[i] = 0.f; S1[i] = 0.f; }
    float gacc0 = 0.f, gacc1 = 0.f;
    {
    const bf16_t* zc0 = Z + (Rs + 8 * w) * ZW + hd * 128 + 2 * kp;
    unsigned nq[8], nk[8], ng[8], nv[8];
#pragma unroll
    for (int i = 0; i < 8; ++i) { const bf16_t* p = zc0 + (size_t)i * ZW; nq[i] = *(const unsigned*)(p + 4096); ng[i] = *(const unsigned*)(p + 5120); nk[i] = *(const unsigned*)(p + 6144); nv[i] = *(const unsigned*)(p + 7168); }
#pragma unroll 1
    for (int c = 0; c < 8; ++c) {
        const size_t R0 = Rs + 64 * c;
        unsigned q2[8], k2[8], v2[8]; float G0[8], G1[8];
        {
            float r0 = 0.f, r1 = 0.f;
#pragma unroll
            for (int i = 0; i < 8; ++i) { q2[i] = nq[i]; k2[i] = nk[i]; v2[i] = nv[i]; r0 += bflo(ng[i]); r1 += bfhi(ng[i]); G0[i] = r0; G1[i] = r1; }
            *(LAS f32x2*)(TOT + w * 128 + 2 * kp) = (f32x2){r0, r1};
        }
        if (c + 1 < 8) {
            const bf16_t* zn = zc0 + (size_t)(64 * (c + 1)) * ZW;
#pragma unroll
            for (int i = 0; i < 8; ++i) { const bf16_t* p = zn + (size_t)i * ZW; nq[i] = *(const unsigned*)(p + 4096); ng[i] = *(const unsigned*)(p + 5120); nk[i] = *(const unsigned*)(p + 6144); nv[i] = *(const unsigned*)(p + 7168); }
        }
        __syncthreads();
        {
            float off0 = 0.f, off1 = 0.f, gm0 = 0.f, gm1 = 0.f, gl0 = 0.f, gl1 = 0.f;
#pragma unroll
            for (int s = 0; s < 8; ++s) {
                const f32x2 tv = *(const LAS f32x2*)(TOT + s * 128 + 2 * kp);
                if (s < w) { off0 += tv.x; off1 += tv.y; }
                if (s < 4) { gm0 += tv.x; gm1 += tv.y; }
                gl0 += tv.x; gl1 += tv.y;
            }
            float ka[8], kb[8];
            bf16_t* qh = QH + (R0 + 8 * w) * WM + hd * 128 + 2 * kp;
#pragma unroll
            for (int i = 0; i < 8; ++i) {
                const float g0 = G0[i] + off0, g1 = G1[i] + off1;
                const float d0 = g0 - gm0, d1 = g1 - gm1;
                const float qf0 = bflo(q2[i]), qf1 = bfhi(q2[i]);
                const float qa = qf0 * __expf(fminf(d0, 80.f)), qb = qf1 * __expf(fminf(d1, 80.f));
                ka[i] = bflo(k2[i]) * __expf(fminf(-d0, 80.f)); kb[i] = bfhi(k2[i]) * __expf(fminf(-d1, 80.f));
                *(LAS unsigned*)(QT + (8 * w + i) * 136 + 2 * kp) = pk2(qa, qb);
                *(LAS unsigned*)(KT + (8 * w + i) * 136 + 2 * kp) = pk2(ka[i], kb[i]);
                *(unsigned*)(qh + (size_t)i * WM) = pk2(qf0 * __expf(g0 + gacc0), qf1 * __expf(g1 + gacc1));
            }
            gacc0 += gl0; gacc1 += gl1;
            u32x4 wa, wb;
            wa.x = pk2(ka[0], ka[1]); wa.y = pk2(ka[2], ka[3]); wa.z = pk2(ka[4], ka[5]); wa.w = pk2(ka[6], ka[7]);
            wb.x = pk2(kb[0], kb[1]); wb.y = pk2(kb[2], kb[3]); wb.z = pk2(kb[4], kb[5]); wb.w = pk2(kb[6], kb[7]);
            *(LAS u32x4*)(KTT + (2 * kp) * 72 + 8 * w) = wa; *(LAS u32x4*)(KTT + (2 * kp + 1) * 72 + 8 * w) = wb;
            wa.x = (v2[0] & 0xffffu) | (v2[1] << 16); wa.y = (v2[2] & 0xffffu) | (v2[3] << 16); wa.z = (v2[4] & 0xffffu) | (v2[5] << 16); wa.w = (v2[6] & 0xffffu) | (v2[7] << 16);
            wb.x = (v2[0] >> 16) | (v2[1] & 0xffff0000u); wb.y = (v2[2] >> 16) | (v2[3] & 0xffff0000u); wb.z = (v2[4] >> 16) | (v2[5] & 0xffff0000u); wb.w = (v2[6] >> 16) | (v2[7] & 0xffff0000u);
            *(LAS u32x4*)(VT + (2 * kp) * 72 + 8 * w) = wa; *(LAS u32x4*)(VT + (2 * kp + 1) * 72 + 8 * w) = wb;
            if (w == 0) { *(LAS f32x2*)(E1 + 2 * kp) = (f32x2){__expf(gm0), __expf(gm1)}; *(LAS f32x2*)(E2 + 2 * kp) = (f32x2){__expf(gl0 - gm0), __expf(gl1 - gm1)}; }
        }
        __syncthreads();
        {
            if (w < 3) {
                const int pm_ = w == 0 ? 0 : 1, ps_ = w == 2 ? 1 : 0;
                f32x16 acc;
#pragma unroll
                for (int i = 0; i < 16; ++i) acc[i] = 0.f;
                mma32(acc, QT + 32 * pm_ * 136, 136, KT + 32 * ps_ * 136, 136, 128, lane);
#pragma unroll
                for (int reg = 0; reg < 16; ++reg) { const int t = 32 * pm_ + row32(reg, lane), s = 32 * ps_ + (lane & 31);
                    PP[t * 72 + s] = f2bf(s <= t ? acc[reg] : 0.f); }
            } else if (w == 3) {
#pragma unroll
                for (int reg = 0; reg < 16; ++reg) PP[row32(reg, lane) * 72 + 32 + (lane & 31)] = 0;
            }
#pragma unroll
            for (int i = 0; i < 4; ++i) {
                const int kk0 = 32 * kt + 8 * i + 4 * (lane >> 5);
                const f32x4 e = *(const LAS f32x4*)(E1 + kk0);
#pragma unroll
                for (int j = 0; j < 4; ++j) { S0[4 * i + j] *= e[j]; S1[4 * i + j] *= e[j]; }
                u32x2 a0, a1; a0.x = pk2(S0[4 * i], S0[4 * i + 1]); a0.y = pk2(S0[4 * i + 2], S0[4 * i + 3]); a1.x = pk2(S1[4 * i], S1[4 * i + 1]); a1.y = pk2(S1[4 * i + 2], S1[4 * i + 3]);
                *(LAS u32x2*)(ST + (32 * vt0 + (lane & 31)) * 136 + kk0) = a0;
                *(LAS u32x2*)(ST + (32 * (vt0 + 1) + (lane & 31)) * 136 + kk0) = a1;
            }
        }
        __syncthreads();
        {
            f32x16 acc;
#pragma unroll
            for (int i = 0; i < 16; ++i) acc[i] = 0.f;
            mma32(acc, QT + 32 * mt * 136, 136, ST + 32 * vt * 136, 136, 128, lane);
            mma32(acc, PP + 32 * mt * 72, 72, VT + 32 * vt * 72, 72, 64, lane);
            float* ol = OL + (R0 + 32 * mt) * WM + hd * 128 + 32 * vt + (lane & 31);
#pragma unroll
            for (int reg = 0; reg < 16; ++reg) ol[(size_t)row32(reg, lane) * WM] = acc[reg];
            mma32(S0, KTT + 32 * kt * 72, 72, VT + 32 * vt0 * 72, 72, 64, lane);
            mma32(S1, KTT + 32 * kt * 72, 72, VT + 32 * (vt0 + 1) * 72, 72, 64, lane);
#pragma unroll
            for (int i = 0; i < 4; ++i) {
                const f32x4 e = *(const LAS f32x4*)(E2 + 32 * kt + 8 * i + 4 * (lane >> 5));
#pragma unroll
                for (int j = 0; j < 4; ++j) { S0[4 * i + j] *= e[j]; S1[4 * i + j] *= e[j]; }
            }
        }
    }
    }
    {
        float* us = USEG + (size_t)item * 16384 + (size_t)(32 * kt) * 128 + 32 * vt0 + (lane & 31);
#pragma unroll
        for (int reg = 0; reg < 16; ++reg) { us[row32(reg, lane) * 128] = S0[reg]; us[row32(reg, lane) * 128 + 32] = S1[reg]; }
        if (w == 0) { DSEG[item * 128 + 2 * kp] = __expf(gacc0); DSEG[item * 128 + 2 * kp + 1] = __expf(gacc1); }
        asm volatile("s_waitcnt vmcnt(0)" ::: "memory");
        __syncthreads();
        if (tid == 0) {
            __builtin_amdgcn_fence(__ATOMIC_RELEASE, "agent");
            asm volatile("s_waitcnt vmcnt(0)" ::: "memory");
            __hip_atomic_store(flags + item, want, __ATOMIC_RELAXED, __HIP_MEMORY_SCOPE_AGENT);
        }
        if (w == 0) {
            if (seg > 0) {
                unsigned spins = 0;
                for (;;) {
                    const int ok = (lane < seg) ? (flag_ld(flags + lane * 16 + bh) >= want) : 1;
                    if (__all(ok)) break;
                    __builtin_amdgcn_s_sleep(2);
                    if (++spins > (1u << 22)) break;
                }
            }
            __builtin_amdgcn_fence(__ATOMIC_ACQUIRE, "agent");
            asm volatile("s_waitcnt vmcnt(0)" ::: "memory");
        }
        __syncthreads();
    }
    {
#pragma unroll
        for (int i = 0; i < 16; ++i) { S0[i] = 0.f; S1[i] = 0.f; }
        if (seg > 0) {
            float dn[16], u0n[16], u1n[16];
            {
                const float* us = USEG + (size_t)bh * 16384 + (size_t)(32 * kt) * 128 + 32 * vt0 + (lane & 31);
                const float* ds = DSEG + bh * 128 + 32 * kt;
#pragma unroll
                for (int reg = 0; reg < 16; ++reg) { dn[reg] = ds[row32(reg, lane)]; u0n[reg] = us[row32(reg, lane) * 128]; u1n[reg] = us[row32(reg, lane) * 128 + 32]; }
            }
#pragma unroll 1
            for (int s2 = 0; s2 < seg; ++s2) {
                float dc[16], u0c[16], u1c[16];
#pragma unroll
                for (int reg = 0; reg < 16; ++reg) { dc[reg] = dn[reg]; u0c[reg] = u0n[reg]; u1c[reg] = u1n[reg]; }
                if (s2 + 1 < seg) {
                    const int it2 = (s2 + 1) * 16 + bh;
                    const float* us = USEG + (size_t)it2 * 16384 + (size_t)(32 * kt) * 128 + 32 * vt0 + (lane & 31);
                    const float* ds = DSEG + it2 * 128 + 32 * kt;
#pragma unroll
                    for (int reg = 0; reg < 16; ++reg) { dn[reg] = ds[row32(reg, lane)]; u0n[reg] = us[row32(reg, lane) * 128]; u1n[reg] = us[row32(reg, lane) * 128 + 32]; }
                }
#pragma unroll
                for (int reg = 0; reg < 16; ++reg) { S0[reg] = dc[reg] * S0[reg] + u0c[reg]; S1[reg] = dc[reg] * S1[reg] + u1c[reg]; }
            }
        }
#pragma unroll
        for (int i = 0; i < 4; ++i) {
            const int kk0 = 32 * kt + 8 * i + 4 * (lane >> 5);
            u32x2 a0, a1; a0.x = pk2(S0[4 * i], S0[4 * i + 1]); a0.y = pk2(S0[4 * i + 2], S0[4 * i + 3]); a1.x = pk2(S1[4 * i], S1[4 * i + 1]); a1.y = pk2(S1[4 * i + 2], S1[4 * i + 3]);
            *(LAS u32x2*)(ST + (32 * vt0 + (lane & 31)) * 136 + kk0) = a0;
            *(LAS u32x2*)(ST + (32 * (vt0 + 1) + (lane & 31)) * 136 + kk0) = a1;
        }
    }
    {
        float nw[16];
#pragma unroll
        for (int i = 0; i < 16; ++i) nw[i] = normw[hd * 128 + cg_ + i];
        const bf16_t* qr = QH + (Rs + t_) * WM + hd * 128 + cg_;
        const bf16_t* zr = Z + (Rs + t_) * ZW + 8192 + hd * 128 + cg_;
        u32x4 h0 = *(const u32x4*)qr, h1 = *(const u32x4*)(qr + 8);
        u32x4 s0 = *(const u32x4*)zr, s1 = *(const u32x4*)(zr + 8);
        const float* ol0 = OL + (Rs + 32 * mt) * WM + hd * 128 + 32 * vt + (lane & 31);
        float oln[16];
#pragma unroll
        for (int reg = 0; reg < 16; ++reg) oln[reg] = ol0[(size_t)row32(reg, lane) * WM];
#pragma unroll 1
        for (int c = 0; c < 8; ++c) {
            const size_t R0 = Rs + 64 * c;
            *(LAS u32x4*)(QT + t_ * 136 + cg_) = h0; *(LAS u32x4*)(QT + t_ * 136 + cg_ + 8) = h1;
            const u32x4 sc0 = s0, sc1 = s1;
            float olv[16];
#pragma unroll
            for (int reg = 0; reg < 16; ++reg) olv[reg] = oln[reg];
            if (c + 1 < 8) {
                h0 = *(const u32x4*)(qr + (size_t)(64 * (c + 1)) * WM); h1 = *(const u32x4*)(qr + (size_t)(64 * (c + 1)) * WM + 8);
                s0 = *(const u32x4*)(zr + (size_t)(64 * (c + 1)) * ZW); s1 = *(const u32x4*)(zr + (size_t)(64 * (c + 1)) * ZW + 8);
#pragma unroll
                for (int reg = 0; reg < 16; ++reg) oln[reg] = ol0[(size_t)(64 * (c + 1) + row32(reg, lane)) * WM];
            }
            __syncthreads();
            {
                f32x16 acc;
#pragma unroll
                for (int i = 0; i < 16; ++i) acc[i] = olv[i];
                mma32(acc, QT + 32 * mt * 136, 136, ST + 32 * vt * 136, 136, 128, lane);
#pragma unroll
                for (int reg = 0; reg < 16; ++reg) Of[(32 * mt + row32(reg, lane)) * 128 + 32 * vt + (lane & 31)] = acc[reg];
            }
            __syncthreads();
            {
                float o[16]; float ss = 0.f;
#pragma unroll
                for (int i = 0; i < 4; ++i) { const f32x4 v = *(const LAS f32x4*)(Of + t_ * 128 + cg_ + 4 * i); o[4 * i] = v[0]; o[4 * i + 1] = v[1]; o[4 * i + 2] = v[2]; o[4 * i + 3] = v[3]; }
#pragma unroll
                for (int i = 0; i < 16; ++i) ss += o[i] * o[i];
                ss += __shfl_xor(ss, 1); ss += __shfl_xor(ss, 2); ss += __shfl_xor(ss, 4);
                const float rs = rsqrtf(ss * (1.0f / 128.0f) + EPS);
#pragma unroll
                for (int j = 0; j < 4; ++j) {
                    o[2 * j] *= rs * nw[2 * j] * bflo(sc0[j]); o[2 * j + 1] *= rs * nw[2 * j + 1] * bfhi(sc0[j]);
                    o[8 + 2 * j] *= rs * nw[8 + 2 * j] * bflo(sc1[j]); o[8 + 2 * j + 1] *= rs * nw[8 + 2 * j + 1] * bfhi(sc1[j]);
                }
                u32x4 w0, w1;
                w0.x = pk2(o[0], o[1]); w0.y = pk2(o[2], o[3]); w0.z = pk2(o[4], o[5]); w0.w = pk2(o[6], o[7]);
                w1.x = pk2(o[8], o[9]); w1.y = pk2(o[10], o[11]); w1.z = pk2(o[12], o[13]); w1.w = pk2(o[14], o[15]);
                bf16_t* yp = Yc + (R0 + t_) * WM + hd * 128 + cg_;
                *(u32x4*)yp = w0; *(u32x4*)(yp + 8) = w1;
            }
        }
    }
    __syncthreads();
}

#define XB_TMO      128
#define XB_XCNT(j)  (256  + 64 * (j))
#define XB_XSUB(j)  (1280 + 64 * (j))
#define XB_XGEN(j)  (2304 + 64 * (j))
#define XB_TOP      3328
#define XB_TOPGEN   3392
#define XCD_BAR_WORDS 3456
#define XB_SPIN_CAP (1u << 22)
__device__ __forceinline__ unsigned xb_ld(unsigned* p)              { return __hip_atomic_load(p, __ATOMIC_RELAXED, __HIP_MEMORY_SCOPE_AGENT); }
__device__ __forceinline__ unsigned xb_add(unsigned* p, unsigned v) { return __hip_atomic_fetch_add(p, v, __ATOMIC_RELAXED, __HIP_MEMORY_SCOPE_AGENT); }
__device__ __forceinline__ unsigned xb_xcc_id() { return (unsigned)__builtin_amdgcn_s_getreg((3 << 11) | 20) & 0xFu; }
#define XB_SPIN(cond, bar) do { unsigned _sp = 0; while (cond) { __builtin_amdgcn_s_sleep(1); \
    if ((++_sp & 255u) == 0u) { if (xb_ld(&(bar)[XB_TMO])) break; if (_sp > XB_SPIN_CAP) { atomicAdd(&(bar)[XB_TMO], 1u); break; } } } } while (0)
struct XcdBarrier { unsigned* bar; unsigned x; volatile LAS unsigned* st; };
__device__ __forceinline__ XcdBarrier xcd_barrier_post(unsigned* bar, volatile LAS unsigned* st) {
    XcdBarrier b; b.bar = bar; b.x = xb_xcc_id(); b.st = st;
    if (threadIdx.x == 0) (void)xb_add(&bar[XB_XCNT(b.x)], 1u);
    return b;
}
__device__ __forceinline__ void xcd_barrier_complete(unsigned* bar, unsigned x, unsigned& nloc, unsigned& nx) {
    const unsigned G = gridDim.x * gridDim.y * gridDim.z;
    unsigned sum, cnt, mine, sp = 0u;
    for (;;) {
        sum = 0u; cnt = 0u; mine = 0u;
#pragma unroll
        for (unsigned j = 0; j < 16; ++j) { const unsigned c = xb_ld(&bar[XB_XCNT(j)]); sum += c; cnt += (c > 0u) ? 1u : 0u; mine = (j == x) ? c : mine; }
        if (sum == G) break;
        __builtin_amdgcn_s_sleep(1);
        if ((++sp & 255u) == 0u) { if (xb_ld(&bar[XB_TMO])) break; if (sp > XB_SPIN_CAP) { atomicAdd(&bar[XB_TMO], 1u); break; } }
    }
    nloc = mine > 0u ? mine : 1u; nx = cnt > 0u ? cnt : 1u;
}
__device__ __forceinline__ void xcd_barrier(const XcdBarrier& b) {
    asm volatile("s_waitcnt vmcnt(0)" ::: "memory");
    __syncthreads();
    if (threadIdx.x == 0) {
        unsigned* bar = b.bar;
        __builtin_amdgcn_s_waitcnt(0);
        unsigned nloc = b.st[0], nx = b.st[1];
        if (nloc == 0u) { xcd_barrier_complete(bar, b.x, nloc, nx); b.st[0] = nloc; b.st[1] = nx; }
        const unsigned old = xb_add(&bar[XB_XSUB(b.x)], 1u);
        const unsigned gen = old / nloc;
        if (old + 1u == (gen + 1u) * nloc) {
            __builtin_amdgcn_fence(__ATOMIC_RELEASE, "agent");
            asm volatile("s_waitcnt vmcnt(0)" ::: "memory");
            const unsigned og = xb_add(&bar[XB_TOP], 1u);
            const unsigned tg = og / nx;
            if (og + 1u == (tg + 1u) * nx) xb_add(&bar[XB_TOPGEN], 1u);
            else XB_SPIN(xb_ld(&bar[XB_TOPGEN]) == tg, bar);
            __builtin_amdgcn_fence(__ATOMIC_ACQUIRE, "agent");
            xb_add(&bar[XB_XGEN(b.x)], 1u);
            asm volatile("s_waitcnt vmcnt(0)" ::: "memory");
        } else {
            XB_SPIN(xb_ld(&bar[XB_XGEN(b.x)]) == gen, bar);
            __builtin_amdgcn_fence(__ATOMIC_ACQUIRE, "agent");
            asm volatile("s_waitcnt vmcnt(0)" ::: "memory");
        }
    }
    __syncthreads();
}

extern "C" __global__ void __launch_bounds__(512, 2) mk_fwd(Args a) {
    extern __shared__ __attribute__((aligned(16))) unsigned char shm[];
    LAS unsigned char* lds = (LAS unsigned char*)shm;
    cg::grid_group grid = cg::this_grid();
    unsigned char* ws = a.ws;
    volatile LAS unsigned* xst = (volatile LAS unsigned*)(lds + LDS_BYTES - 16);
    if (threadIdx.x == 0) { xst[0] = 0u; xst[1] = 0u; }
    __syncthreads();
    const XcdBarrier xb = xcd_barrier_post((unsigned*)(ws + OFF_BAR), xst);
    const int G = gridDim.x, bid = blockIdx.x;
    u64* ssq = (u64*)(ws + OFF_SSQ);
    bf16_t* Xb = (bf16_t*)(ws + OFF_XB);
    bf16_t* Z = (bf16_t*)(ws + OFF_Z);
    bf16_t* Ypre = (bf16_t*)(ws + OFF_YPRE);
    bf16_t* Y3 = (bf16_t*)(ws + OFF_Y3);
    bf16_t* Mrg = (bf16_t*)(ws + OFF_MRG);

    phase_prep(a, lds);
    grid.sync();

#pragma unroll 1
    for (int l = 0; l < DEPTH; ++l) {
        {
            pg8::Gemm g{Xb, (const bf16_t*)(ws + OFF_WIN) + (size_t)l * NIN * DM, T_TOK, NIN, DM, 0, 0};
            pg8::StaticOrder S; S.init(T_TOK, NIN, G, bid);
            EpiZ E{Z, ssq + l * T_TOK, (const float*)(ws + OFF_LBS) + l * WM};
            pg8::gemm_phase(lds, g, S, E);
        }
        GSYNC();
        {
            {
                const int bn0 = bid & 31, n0 = bn0 & 15;
                const RgSetup st = rg_setup((const bf16_t*)(ws + OFF_RGW) + (size_t)(l * 16 + n0) * 8192, a.in[13] + l * 4 * WM, a.in[14] + l * WM,
                                            a.in[16] + l * WM, a.in[18] + l * WM, a.in[19] + l * WM, n0);
#pragma unroll 1
                for (int j = 0; j < 5; ++j) {
                    int it;
                    if (j < 3) it = bid + 256 * j; else { if (bid < 128) break; it = 768 + (bid - 128) + 128 * (j - 3); }
                    const int seg = it >> 5, bn = it & 31, b = bn >> 4, n = bn & 15;
                    rg_item(lds, Z, Y3 + (size_t)T_TOK * WM, st, seg, b, n, (float*)(ws + OFF_RGS), (unsigned*)(ws + OFF_FLG), (unsigned)(l + 1));
                }
            }
            if (bid < 128) {
                const int b = bid >> 6, g = bid & 63;
                s5_item(lds, Z, Ypre, (const float2*)(ws + OFF_S5A) + (l * 64 + g) * 64, (const bf16_t*)(ws + OFF_S5BT) + (size_t)(l * 64 + g) * 2048,
                        (const bf16_t*)(ws + OFF_S5CT) + (size_t)(l * 64 + g) * 2048, a.in[10] + l * WM, b, g);
                {
                    pg8::Gemm g2{Ypre, (const bf16_t*)(ws + OFF_WGLU) + (size_t)l * WM * WM, T_TOK, WM, WM, 0, 0};
                    pg8::StaticOrder S; S.init(T_TOK, WM, 128, bid);
                    pg8::Unit u0; S.next(0, u0);
                    unsigned* s5cnt = (unsigned*)(ws + OFF_FLG) + 2048;
                    asm volatile("s_waitcnt vmcnt(0)" ::: "memory");
                    __syncthreads();
                    if (threadIdx.x == 0) {
                        __builtin_amdgcn_fence(__ATOMIC_RELEASE, "agent");
                        asm volatile("s_waitcnt vmcnt(0)" ::: "memory");
                        __hip_atomic_fetch_add(s5cnt + 64 * b, 1u, __ATOMIC_RELAXED, __HIP_MEMORY_SCOPE_AGENT);
                        unsigned spins = 0;
                        while (__hip_atomic_load(s5cnt + 64 * (u0.pm >> 4), __ATOMIC_RELAXED, __HIP_MEMORY_SCOPE_AGENT) < 64u * (unsigned)(l + 1)) {
                            __builtin_amdgcn_s_sleep(2); if (++spins > (1u << 22)) break; }
                        __builtin_amdgcn_fence(__ATOMIC_ACQUIRE, "agent");
                        asm volatile("s_waitcnt vmcnt(0)" ::: "memory");
                    }
                    __syncthreads();
                    EpiGlu E{Ypre, Z, a.in[12] + l * WM, Y3};
                    pg8::gemm_phase(lds, g2, S, E);
                }
            } else {
                const int i = bid - 128, seg = i >> 4, bh = i & 15;
                hg_item(lds, Z, Y3 + (size_t)2 * T_TOK * WM, a.in[21] + l * WM, bh >> 3, bh & 7, seg, (float*)(ws + OFF_OL), (bf16_t*)(ws + OFF_QH),
                        (float*)(ws + OFF_USEG), (float*)(ws + OFF_DSEG), (unsigned*)(ws + OFF_FLG) + 1024, (unsigned)(l + 1));
            }
        }
        GSYNC();
        {
            pg8::Gemm g{Y3, (const bf16_t*)(ws + OFF_WBR) + (size_t)l * 3 * DM * WM, T_TOK, DM, WM, (size_t)T_TOK * WM * 2, (size_t)DM * WM * 2};
            pg8::Order3 S; S.init(T_TOK, DM, G, bid);
            EpiBr E{Z, Mrg};
            pg8::gemm_phase(lds, g, S, E);
        }
        GSYNC();
        {
            pg8::Gemm g{Mrg, (const bf16_t*)(ws + OFF_WOUT) + (size_t)l * DM * DM, T_TOK, DM, DM, 0, 0};
            pg8::StaticOrder S; S.init(T_TOK, DM, G, bid);
            EpiOut E{l == 0 ? a.in[0] : nullptr, Xb, ssq + (l + 1) * T_TOK};
            pg8::gemm_phase(lds, g, S, E);
        }
        GSYNC();
    }
    {
        const int tid = opaque_tid(), lane = tid & 63, wave = tid >> 6;
        const float* fw = a.in[24]; const u64* sq = ssq + 4 * T_TOK;
        for (int row = bid * 8 + wave; row < T_TOK; row += G * 8) {
            const float rs = ssq_rstd(sq + row);
#pragma unroll
            for (int j = 0; j < 8; ++j) {
                const int col = 4 * lane + 256 * j;
                const u32x2 xw = *(const u32x2*)(Xb + (size_t)row * DM + col); const f32x4 v = (f32x4){bflo(xw.x), bfhi(xw.x), bflo(xw.y), bfhi(xw.y)}; const f32x4 wv = *(const f32x4*)(fw + col);
                *(f32x4*)(a.out + (size_t)row * DM + col) = v * rs * wv;
            }
        }
    }
}

extern "C" void kernel_launch(void* const* d_in, const int* in_sizes, int n_in, void* d_out, int out_size, void* d_ws, size_t ws_size, hipStream_t stream) {
    static int grid = 0;
    if (grid == 0) {
        if (n_in != 25 || ws_size < WS_END) { fprintf(stderr, "kernel_launch: unexpected n_in %d or ws_size %zu (need %zu)\n", n_in, ws_size, (size_t)WS_END); grid = -1; return; }
        int dev = 0, cus = 0, per = 0;
        (void)hipGetDevice(&dev); (void)hipDeviceGetAttribute(&cus, hipDeviceAttributeMultiprocessorCount, dev);
        if (hipFuncSetAttribute((const void*)mk_fwd, hipFuncAttributeMaxDynamicSharedMemorySize, LDS_BYTES) != hipSuccess) fprintf(stderr, "kernel_launch: hipFuncSetAttribute failed\n");
        (void)hipOccupancyMaxActiveBlocksPerMultiprocessor(&per, (const void*)mk_fwd, 512, LDS_BYTES);
        (void)hipGetLastError();
        grid = cus > 0 ? cus : 256;
        if (grid > 256) grid = 256;
    }
    if (grid < 0) return;
    (void)hipMemsetAsync((unsigned char*)d_ws + OFF_BAR, 0, 32768, stream);
    Args a{};
    for (int i = 0; i < 25; ++i) a.in[i] = (const float*)d_in[i];
    a.out = (float*)d_out; a.ws = (unsigned char*)d_ws;
    void* args[] = {&a};
    hipError_t e = hipLaunchCooperativeKernel((void*)mk_fwd, dim3(grid), dim3(512), args, LDS_BYTES, stream);
    if (e != hipSuccess) fprintf(stderr, "cooperative launch failed: %s (grid %d)\n", hipGetErrorString(e), grid);
}
```

```cpp
#include <hip/hip_runtime.h>
#include <hip/hip_cooperative_groups.h>
#include <cstdio>
#include <cstdint>
namespace cg = cooperative_groups;
#define GSYNC() xcd_barrier(xb)

#define LAS __attribute__((address_space(3)))
typedef unsigned short bf16_t;
typedef short bf16x8 __attribute__((ext_vector_type(8)));
typedef float f32x4 __attribute__((ext_vector_type(4)));
typedef float f32x16 __attribute__((ext_vector_type(16)));
typedef unsigned u32x4 __attribute__((ext_vector_type(4)));
typedef unsigned u32x2 __attribute__((ext_vector_type(2)));
typedef unsigned long long u64;
typedef float f32x2 __attribute__((ext_vector_type(2)));
__device__ __forceinline__ float ssq_rstd(const u64* p) { return rsqrtf((float)(*p) * (1.0f / (16777216.0f * 2048.0f)) + 1e-6f); }

constexpr int T_TOK = 8192, SEQ = 4096, DM = 2048, WM = 1024, NIN = 14336, DEPTH = 4;
constexpr int ZW = 15360;
constexpr float EPS = 1e-6f;
constexpr int LDS_BYTES = 163840;

constexpr size_t OFF_SSQ = 0;
constexpr size_t OFF_LBS = 327680;
constexpr size_t OFF_S5A = 344064;
constexpr size_t OFF_S5BT = 475136;
constexpr size_t OFF_S5CT = 1523712;
constexpr size_t OFF_RGW = 2572288;
constexpr size_t OFF_BAR = 3670016;
constexpr size_t OFF_WIN = 4194304;
constexpr size_t OFF_WGLU = OFF_WIN + 234881024ull;
constexpr size_t OFF_WBR = OFF_WGLU + 8388608ull;
constexpr size_t OFF_WOUT = OFF_WBR + 50331648ull;
constexpr size_t OFF_X = OFF_WOUT + 33554432ull;
constexpr size_t OFF_XB = OFF_X + 67108864ull;
constexpr size_t OFF_Z = OFF_XB + 33554432ull;
constexpr size_t OFF_YPRE = OFF_Z + 251658240ull;
constexpr size_t OFF_Y3 = OFF_YPRE + 16777216ull;
constexpr size_t OFF_MRG = OFF_Y3 + 50331648ull;
constexpr size_t OFF_RGS = OFF_MRG + 33554432ull;
constexpr size_t OFF_OL = OFF_RGS + 524288ull;
constexpr size_t OFF_QH = OFF_OL + 33554432ull;
constexpr size_t OFF_USEG = OFF_QH + 16777216ull;
constexpr size_t OFF_DSEG = OFF_USEG + 8388608ull;
constexpr size_t WS_END = OFF_DSEG + 65536ull;
constexpr size_t OFF_FLG = OFF_BAR + 16384;

__device__ __forceinline__ unsigned pk2(float lo, float hi) { unsigned r; asm("v_cvt_pk_bf16_f32 %0, %1, %2" : "=v"(r) : "v"(lo), "v"(hi)); return r; }
__device__ __forceinline__ unsigned pk2t(float lo, float hi) { unsigned r; asm("s_nop 1\n\tv_cvt_pk_bf16_f32 %0, %1, %2" : "=v"(r) : "v"(lo), "v"(hi)); return r; }
__device__ __forceinline__ bf16_t f2bf(float f) { return (bf16_t)(pk2(f, 0.f) & 0xffffu); }
__device__ __forceinline__ float bf2f(bf16_t b) { return __uint_as_float(((unsigned)b) << 16); }
__device__ __forceinline__ float bflo(unsigned w) { return __uint_as_float(w << 16); }
__device__ __forceinline__ float bfhi(unsigned w) { return __uint_as_float(w & 0xffff0000u); }
__device__ __forceinline__ float sigmoidf_(float v) { return __builtin_amdgcn_rcpf(1.0f + __expf(-v)); }
#define LDS_WAIT() asm volatile("s_waitcnt lgkmcnt(0)" ::: "memory")
__device__ __forceinline__ int opaque_tid() { int t = threadIdx.x; asm volatile("" : "+v"(t)); return t; }

namespace pg8 {
constexpr int BM = 256, BK = 64, HALF = 128, HTB = HALF * BK * 2, STAGE_BYTES = 8 * HTB, NXCD = 8, WGM = 8;
__host__ __device__ __forceinline__ int lds_byte(int r, int c) { const int st = (r >> 4) * 2 + (c >> 5), rr = r & 15, cc = c & 31, ob = rr * 64 + cc * 2; return st * 1024 + (ob ^ (((ob >> 9) & 1) << 5)); }
__host__ __device__ __forceinline__ void stage_rc(int b, int& R, int& C) { const int st = b / 1024, sb = b % 1024, swz = sb ^ (((sb >> 9) & 1) << 5); R = (st >> 1) * 16 + swz / 64; C = (st & 1) * 32 + (swz % 64) / 2; }
__host__ __device__ __forceinline__ int perm32(int rho) { const int n = rho >> 4, i = rho & 15; return 8 * (i >> 2) + 4 * n + (i & 3); }

struct Unit { int pm, pn, br; };
struct Gemm { const bf16_t* A; const bf16_t* Bt; int M, N, K; size_t sA, sB; };

struct StaticOrder {
    int nM, nN, nwg, G, c;
    __device__ void init(int M, int N, int G_, int c_) { nM = M / BM; nN = N / BM; nwg = nM * nN; G = G_; c = c_; }
    __device__ __forceinline__ bool next(int i, Unit& u) const {
        const long L = (long)i * G + c; if (L >= nwg) return false;
        int wgid = (int)L; { const int q = nwg / NXCD, r = nwg % NXCD, xcd = wgid % NXCD, off = wgid / NXCD; wgid = (xcd < r ? xcd * (q + 1) : r * (q + 1) + (xcd - r) * q) + off; }
        const int nig = WGM * nN, gid = wgid / nig, fm = gid * WGM, gsz = (nM - fm) < WGM ? (nM - fm) : WGM;
        u.pm = fm + ((wgid % nig) % gsz); u.pn = (wgid % nig) / gsz; u.br = 0; return true;
    }
};
struct Order3 : StaticOrder {
    __device__ __forceinline__ bool next(int i, Unit& u) const { if (!StaticOrder::next(i / 3, u)) return false; u.br = i % 3; return true; }
};

template <class Epi, class Sched>
__device__ __forceinline__ void gemm_phase(LAS unsigned char* lds, const Gemm g, const Sched& S, const Epi& E) {
    const int tid = opaque_tid(), wid = __builtin_amdgcn_readfirstlane(tid >> 6), lane = tid & 63, wr = wid >> 2, wc = wid & 3, fr = lane & 15, fq = lane >> 4;
    const int K = g.K, nt = K / BK;
    unsigned voffA[2], voffB[2];
#pragma unroll
    for (int i = 0; i < 2; ++i) { int R, C; stage_rc(tid * 16 + i * 8192, R, C); const int Rb = (R & ~31) + perm32(R & 31);
        voffA[i] = (unsigned)(R * K + C) * 2u; voffB[i] = (unsigned)(Rb * K + C) * 2u; }
    const size_t kstep = (size_t)(BK * 2);
    const size_t hstep = (size_t)HALF * K * 2;
    const size_t tstep = 2 * hstep;
    const unsigned ldsw = (unsigned)wid * 1024u;
    const int aoff = lds_byte(wr * 64 + fr, fq * 8), boff = lds_byte(wc * 32 + fr, fq * 8);
#define PG8_SA(b, h) (((b) * 2 + (h)) * HTB)
#define PG8_SB(b, h) ((4 + (b) * 2 + (h)) * HTB)
#define PG8_STAGE(bufoff, gbase, voff) do { _Pragma("unroll") for (int _i = 0; _i < 2; ++_i) \
        __builtin_amdgcn_global_load_lds((const unsigned*)((const char*)(gbase) + (voff)[_i]), (LAS unsigned*)(lds + (bufoff) + ldsw + _i * 8192), 16, 0, 0); } while (0)
#define PG8_LDA(dst, b, h) do { _Pragma("unroll") for (int m = 0; m < 4; ++m) _Pragma("unroll") for (int k = 0; k < 2; ++k) dst[m][k] = *(const LAS bf16x8*)(lds + PG8_SA(b, h) + aoff + m * 2048 + k * 1024); } while (0)
#define PG8_LDB(dst, b, h) do { _Pragma("unroll") for (int n = 0; n < 2; ++n) _Pragma("unroll") for (int k = 0; k < 2; ++k) dst[n][k] = *(const LAS bf16x8*)(lds + PG8_SB(b, h) + boff + n * 2048 + k * 1024); } while (0)
#define PG8_MMA(ai, bj, At, Bt) do { __builtin_amdgcn_s_setprio(1); _Pragma("unroll") for (int m = 0; m < 4; ++m) _Pragma("unroll") for (int n = 0; n < 2; ++n) _Pragma("unroll") for (int k = 0; k < 2; ++k) \
        acc[ai][bj][m][n] = __builtin_amdgcn_mfma_f32_16x16x32_bf16(Bt[n][k], At[m][k], acc[ai][bj][m][n], 0, 0, 0); __builtin_amdgcn_s_setprio(0); } while (0)
#define PG8_WAIT_V(n) asm volatile("s_waitcnt vmcnt(" #n ")" ::: "memory")
#define PG8_WAIT_L(n) asm volatile("s_waitcnt lgkmcnt(" #n ")" ::: "memory")
#define PG8_BAR __builtin_amdgcn_s_barrier()
#define PG8_SCHED __builtin_amdgcn_sched_barrier(0)
    Unit cur, nxt; int ui = 0;
    if (!S.next(0, cur)) return;
    f32x4 acc[2][2][4][2];
#pragma unroll
    for (int a = 0; a < 2; ++a)
#pragma unroll
        for (int b = 0; b < 2; ++b)
#pragma unroll
            for (int m = 0; m < 4; ++m)
#pragma unroll
                for (int n = 0; n < 2; ++n) acc[a][b][m][n] = (f32x4){0.f, 0.f, 0.f, 0.f};
    bf16x8 At[4][2], B0[2][2], B1[2][2];
    const char* cA = (const char*)g.A + (size_t)cur.br * g.sA + (size_t)cur.pm * tstep; const char* cB = (const char*)g.Bt + (size_t)cur.br * g.sB + (size_t)cur.pn * tstep;
    PG8_STAGE(PG8_SB(0, 0), cB, voffB); PG8_STAGE(PG8_SB(0, 1), cB + hstep, voffB); PG8_STAGE(PG8_SA(0, 0), cA, voffA); PG8_STAGE(PG8_SA(0, 1), cA + hstep, voffA);
    if (wr == 1) PG8_BAR;
    PG8_WAIT_V(2); PG8_BAR;
    PG8_STAGE(PG8_SB(1, 0), cB + kstep, voffB); PG8_STAGE(PG8_SA(1, 0), cA + kstep, voffA); PG8_STAGE(PG8_SB(1, 1), cB + hstep + kstep, voffB);
    PG8_WAIT_V(6); PG8_BAR;
    for (;;) {
        const bool has_next = S.next(ui + 1, nxt);
        const char* nA = has_next ? (const char*)g.A + (size_t)nxt.br * g.sA + (size_t)nxt.pm * tstep : cA; const char* nB = has_next ? (const char*)g.Bt + (size_t)nxt.br * g.sB + (size_t)nxt.pn * tstep : cB;
        for (int t = 0; t < nt; t += 2) {
            const bool last = (t == nt - 2);
            const char* a1 = cA + (size_t)(t + 1) * kstep;
            const char* a2 = last ? nA : cA + (size_t)(t + 2) * kstep; const char* b2 = last ? nB : cB + (size_t)(t + 2) * kstep;
            const char* a3 = a2 + kstep; const char* b3 = b2 + kstep;
            PG8_LDB(B0, 0, 0); PG8_LDB(B1, 0, 1); PG8_SCHED; PG8_LDA(At, 0, 0); PG8_STAGE(PG8_SA(1, 1), a1 + hstep, voffA);
            PG8_WAIT_V(8); PG8_WAIT_L(0); PG8_BAR; PG8_MMA(0, 0, At, B0); PG8_MMA(0, 1, At, B1); PG8_BAR; PG8_SCHED;
            PG8_LDA(At, 0, 1); PG8_STAGE(PG8_SB(0, 0), b2, voffB); PG8_STAGE(PG8_SB(0, 1), b2 + hstep, voffB); PG8_STAGE(PG8_SA(0, 0), a2, voffA);
            PG8_WAIT_V(8); PG8_WAIT_L(0); PG8_BAR; PG8_MMA(1, 0, At, B0); PG8_MMA(1, 1, At, B1); PG8_BAR; PG8_SCHED;
            PG8_LDB(B0, 1, 0); PG8_LDB(B1, 1, 1); PG8_SCHED; PG8_LDA(At, 1, 0); PG8_STAGE(PG8_SA(0, 1), a2 + hstep, voffA);
            PG8_WAIT_V(8); PG8_WAIT_L(0); PG8_BAR; PG8_MMA(0, 0, At, B0); PG8_MMA(0, 1, At, B1); PG8_BAR; PG8_SCHED;
            PG8_LDA(At, 1, 1); PG8_STAGE(PG8_SB(1, 0), b3, voffB); PG8_STAGE(PG8_SB(1, 1), b3 + hstep, voffB); PG8_STAGE(PG8_SA(1, 0), a3, voffA);
            PG8_WAIT_V(8); PG8_WAIT_L(0); PG8_BAR; PG8_MMA(1, 0, At, B0); PG8_MMA(1, 1, At, B1); PG8_BAR; PG8_SCHED;
        }
        if (wr == 0) PG8_BAR;
        const bool reset = E(acc, cur, wr, wc, fr, fq);
        if (!has_next) break;
        if (reset) {
#pragma unroll
            for (int a = 0; a < 2; ++a)
#pragma unroll
                for (int b = 0; b < 2; ++b)
#pragma unroll
                    for (int m = 0; m < 4; ++m)
#pragma unroll
                        for (int n = 0; n < 2; ++n) acc[a][b][m][n] = (f32x4){0.f, 0.f, 0.f, 0.f};
        }
        cur = nxt; cA = nA; cB = nB; ++ui;
        if (wr == 1) PG8_BAR;
    }
    PG8_WAIT_V(0);
    PG8_BAR;
#undef PG8_SA
#undef PG8_SB
#undef PG8_STAGE
#undef PG8_LDA
#undef PG8_LDB
#undef PG8_MMA
#undef PG8_WAIT_V
#undef PG8_WAIT_L
#undef PG8_BAR
#undef PG8_SCHED
}
}
using pg8::Unit;

struct EpiZ {
    bf16_t* Z; const u64* ssq; const float* lbs;
    __device__ __forceinline__ bool operator()(f32x4 (&acc)[2][2][4][2], const Unit& u, int wr, int wc, int fr, int fq) const {
        const int seg = u.pn < 32 ? (u.pn >> 2) : 8;
        const int mode = (seg == 8) ? 2 : (seg == 5 ? 3 : ((seg == 1 || seg == 3 || seg == 4 || seg == 7) ? 1 : 0));
        const int zadd = seg >= 6 ? 1024 : 0;
        float rs[2][4];
#pragma unroll
        for (int ai = 0; ai < 2; ++ai)
#pragma unroll
            for (int m = 0; m < 4; ++m) rs[ai][m] = ssq_rstd(ssq + u.pm * 256 + ai * 128 + wr * 64 + m * 16 + fr);
        f32x4 lbv[2][2];
#pragma unroll
        for (int bj = 0; bj < 2; ++bj) {
            const int cl = (mode == 3) ? (u.pn * 256 + bj * 128 + wc * 32 + 8 * fq - 5120) : 0;
            lbv[bj][0] = *(const f32x4*)(lbs + cl); lbv[bj][1] = *(const f32x4*)(lbs + cl + 4);
        }
#pragma unroll
        for (int ai = 0; ai < 2; ++ai)
#pragma unroll
            for (int m = 0; m < 4; ++m) {
                const int row = u.pm * 256 + ai * 128 + wr * 64 + m * 16 + fr;
#pragma unroll
                for (int bj = 0; bj < 2; ++bj) {
                    const int c = u.pn * 256 + bj * 128 + wc * 32 + 8 * fq;
                    float v[8];
#pragma unroll
                    for (int j = 0; j < 4; ++j) { v[j] = acc[ai][bj][m][0][j] * rs[ai][m]; v[4 + j] = acc[ai][bj][m][1][j] * rs[ai][m]; }
                    bf16_t* zp = Z + (size_t)row * ZW + c + zadd;
                    if (mode == 3) {
                        float gl[8], kk[8];
#pragma unroll
                        for (int j = 0; j < 8; ++j) {
                            const float lb = j < 4 ? lbv[bj][0][j] : lbv[bj][1][j - 4];
                            const float e = __expf(-v[j]); const float sg = __builtin_amdgcn_rcpf(1.0f + e);
                            const float f = lb + (1.0f - lb) * sg;
                            gl[j] = __logf(f); kk[j] = (1.0f - lb) * (e * sg);
                        }
                        u32x4 w0, w1;
                        w0.x = pk2(gl[0], gl[1]); w0.y = pk2(gl[2], gl[3]); w0.z = pk2(gl[4], gl[5]); w0.w = pk2(gl[6], gl[7]);
                        w1.x = pk2(kk[0], kk[1]); w1.y = pk2(kk[2], kk[3]); w1.z = pk2(kk[4], kk[5]); w1.w = pk2(kk[6], kk[7]);
                        *(u32x4*)zp = w0; *(u32x4*)(zp + 1024) = w1;
                    } else {
                        float o[8];
                        if (mode == 0) {
#pragma unroll
                            for (int j = 0; j < 8; ++j) o[j] = v[j];
                        } else if (mode == 1) {
#pragma unroll
                            for (int j = 0; j < 8; ++j) o[j] = v[j] * __builtin_amdgcn_rcpf(1.0f + __expf(-v[j]));
                        } else {
#pragma unroll
                            for (int j = 0; j < 8; ++j) o[j] = __builtin_amdgcn_rcpf(1.0f + __expf(-v[j]));
                        }
                        u32x4 w0; w0.x = pk2t(o[0], o[1]); w0.y = pk2t(o[2], o[3]); w0.z = pk2t(o[4], o[5]); w0.w = pk2t(o[6], o[7]);
                        *(u32x4*)zp = w0;
                    }
                }
            }
        return true;
    }
};
struct EpiGlu {
    const bf16_t* Ypre; const bf16_t* Z; const float* bglu; bf16_t* Ya;
    __device__ __forceinline__ bool operator()(f32x4 (&acc)[2][2][4][2], const Unit& u, int wr, int wc, int fr, int fq) const {
        f32x4 bv[2][2];
#pragma unroll
        for (int bj = 0; bj < 2; ++bj) { const int c = u.pn * 256 + bj * 128 + wc * 32 + 8 * fq; bv[bj][0] = *(const f32x4*)(bglu + c); bv[bj][1] = *(const f32x4*)(bglu + c + 4); }
#pragma unroll
        for (int ai = 0; ai < 2; ++ai) {
            u32x4 yp[4][2], sg[4][2];
#pragma unroll
            for (int m = 0; m < 4; ++m)
#pragma unroll
                for (int bj = 0; bj < 2; ++bj) {
                    const int row = u.pm * 256 + ai * 128 + wr * 64 + m * 16 + fr, c = u.pn * 256 + bj * 128 + wc * 32 + 8 * fq;
                    yp[m][bj] = *(const u32x4*)(Ypre + (size_t)row * WM + c); sg[m][bj] = *(const u32x4*)(Z + (size_t)row * ZW + 1024 + c);
                }
            __builtin_amdgcn_sched_barrier(0);
#pragma unroll
            for (int m = 0; m < 4; ++m)
#pragma unroll
                for (int bj = 0; bj < 2; ++bj) {
                    const int row = u.pm * 256 + ai * 128 + wr * 64 + m * 16 + fr, c = u.pn * 256 + bj * 128 + wc * 32 + 8 * fq;
                    float o[8];
#pragma unroll
                    for (int j = 0; j < 8; ++j) {
                        const float a = (j < 4 ? acc[ai][bj][m][0][j] : acc[ai][bj][m][1][j - 4]) + (j < 4 ? bv[bj][0][j] : bv[bj][1][j - 4]);
                        const unsigned ypw = yp[m][bj][j >> 1], sgw = sg[m][bj][j >> 1];
                        const float y = (j & 1) ? bfhi(ypw) : bflo(ypw), s = (j & 1) ? bfhi(sgw) : bflo(sgw);
                        o[j] = y * sigmoidf_(a) * s;
                    }
                    u32x4 w0; w0.x = pk2(o[0], o[1]); w0.y = pk2(o[2], o[3]); w0.z = pk2(o[4], o[5]); w0.w = pk2(o[6], o[7]);
                    *(u32x4*)(Ya + (size_t)row * WM + c) = w0;
                }
            __builtin_amdgcn_sched_barrier(0);
        }
        return true;
    }
};
struct EpiBr {
    const bf16_t* Z; bf16_t* Mrg;
    __device__ __forceinline__ bool operator()(f32x4 (&acc)[2][2][4][2], const Unit& u, int wr, int wc, int fr, int fq) const {
        const int br = u.br, nb = br < 2 ? br + 1 : br;
#pragma unroll
        for (int ai = 0; ai < 2; ++ai) {
            u32x4 ga[4][2], gb[4][2];
#pragma unroll
            for (int m = 0; m < 4; ++m)
#pragma unroll
                for (int bj = 0; bj < 2; ++bj) {
                    const int row = u.pm * 256 + ai * 128 + wr * 64 + m * 16 + fr, c = u.pn * 256 + bj * 128 + wc * 32 + 8 * fq;
                    const bf16_t* gp = Z + (size_t)row * ZW + 9216 + c;
                    ga[m][bj] = *(const u32x4*)(gp + br * 2048); gb[m][bj] = *(const u32x4*)(gp + nb * 2048);
                }
            __builtin_amdgcn_sched_barrier(0);
#pragma unroll
            for (int m = 0; m < 4; ++m)
#pragma unroll
                for (int bj = 0; bj < 2; ++bj) {
                    const int row = u.pm * 256 + ai * 128 + wr * 64 + m * 16 + fr, c = u.pn * 256 + bj * 128 + wc * 32 + 8 * fq;
                    if (br < 2) {
#pragma unroll
                        for (int j = 0; j < 8; ++j) {
                            const unsigned aw = ga[m][bj][j >> 1], bw = gb[m][bj][j >> 1];
                            const float x = (j & 1) ? bfhi(aw) : bflo(aw), y = (j & 1) ? bfhi(bw) : bflo(bw);
                            const float r = x * __builtin_amdgcn_rcpf(fmaxf(y, 1e-30f));
                            if (j < 4) acc[ai][bj][m][0][j] *= r; else acc[ai][bj][m][1][j - 4] *= r;
                        }
                    } else {
                        float o[8];
#pragma unroll
                        for (int j = 0; j < 8; ++j) {
                            const unsigned aw = ga[m][bj][j >> 1];
                            const float x = (j & 1) ? bfhi(aw) : bflo(aw);
                            o[j] = (j < 4 ? acc[ai][bj][m][0][j] : acc[ai][bj][m][1][j - 4]) * x;
                        }
                        u32x4 w0; w0.x = pk2(o[0], o[1]); w0.y = pk2(o[2], o[3]); w0.z = pk2(o[4], o[5]); w0.w = pk2(o[6], o[7]);
                        *(u32x4*)(Mrg + (size_t)row * DM + c) = w0;
                    }
                }
            __builtin_amdgcn_sched_barrier(0);
        }
        return br == 2;
    }
};
struct EpiOut {
    const float* Xin; bf16_t* Xb; u64* ssq;
    __device__ __forceinline__ bool operator()(f32x4 (&acc)[2][2][4][2], const Unit& u, int wr, int wc, int fr, int fq) const {
        const bool first = Xin != nullptr;
#pragma unroll
        for (int ai = 0; ai < 2; ++ai) {
            if (first) {
                f32x4 xi[4][2][2];
#pragma unroll
                for (int m = 0; m < 4; ++m)
#pragma unroll
                    for (int bj = 0; bj < 2; ++bj) {
                        const int row = u.pm * 256 + ai * 128 + wr * 64 + m * 16 + fr, c = u.pn * 256 + bj * 128 + wc * 32 + 8 * fq;
                        xi[m][bj][0] = *(const f32x4*)(Xin + (size_t)row * DM + c); xi[m][bj][1] = *(const f32x4*)(Xin + (size_t)row * DM + c + 4);
                    }
                __builtin_amdgcn_sched_barrier(0);
#pragma unroll
                for (int m = 0; m < 4; ++m)
#pragma unroll
                    for (int bj = 0; bj < 2; ++bj) { acc[ai][bj][m][0] += xi[m][bj][0]; acc[ai][bj][m][1] += xi[m][bj][1]; }
            } else {
                u32x4 xw[4][2];
#pragma unroll
                for (int m = 0; m < 4; ++m)
#pragma unroll
                    for (int bj = 0; bj < 2; ++bj) {
                        const int row = u.pm * 256 + ai * 128 + wr * 64 + m * 16 + fr, c = u.pn * 256 + bj * 128 + wc * 32 + 8 * fq;
                        xw[m][bj] = *(const u32x4*)(Xb + (size_t)row * DM + c);
                    }
                __builtin_amdgcn_sched_barrier(0);
#pragma unroll
                for (int m = 0; m < 4; ++m)
#pragma unroll
                    for (int bj = 0; bj < 2; ++bj) {
                        const u32x4 w = xw[m][bj];
                        acc[ai][bj][m][0] += (f32x4){bflo(w.x), bfhi(w.x), bflo(w.y), bfhi(w.y)}; acc[ai][bj][m][1] += (f32x4){bflo(w.z), bfhi(w.z), bflo(w.w), bfhi(w.w)};
                    }
            }
#pragma unroll
            for (int m = 0; m < 4; ++m) {
                const int row = u.pm * 256 + ai * 128 + wr * 64 + m * 16 + fr;
                float part = 0.f;
#pragma unroll
                for (int bj = 0; bj < 2; ++bj) {
                    const int c = u.pn * 256 + bj * 128 + wc * 32 + 8 * fq;
                    const f32x4 v0 = acc[ai][bj][m][0], v1 = acc[ai][bj][m][1];
                    u32x4 w0; w0.x = pk2(v0[0], v0[1]); w0.y = pk2(v0[2], v0[3]); w0.z = pk2(v1[0], v1[1]); w0.w = pk2(v1[2], v1[3]);
                    *(u32x4*)(Xb + (size_t)row * DM + c) = w0;
                    part += v0[0] * v0[0] + v0[1] * v0[1] + v0[2] * v0[2] + v0[3] * v0[3] + v1[0] * v1[0] + v1[1] * v1[1] + v1[2] * v1[2] + v1[3] * v1[3];
                }
                part += __shfl_xor(part, 16); part += __shfl_xor(part, 32);
                if (fq == 0) atomicAdd(ssq + row, (u64)(part * 16777216.0f));
            }
            __builtin_amdgcn_sched_barrier(0);
        }
        return true;
    }
};

__device__ __forceinline__ void mma32(f32x16& acc, const LAS bf16_t* A, int lda, const LAS bf16_t* Bt, int ldb, int K, int lane) {
    const int r = lane & 31, h = lane >> 5;
    const LAS bf16_t* pa = A + r * lda + 8 * h; const LAS bf16_t* pb = Bt + r * ldb + 8 * h;
    for (int k = 0; k < K; k += 16) {
        const bf16x8 a = *(const LAS bf16x8*)(pa + k); const bf16x8 b = *(const LAS bf16x8*)(pb + k);
        acc = __builtin_amdgcn_mfma_f32_32x32x16_bf16(a, b, acc, 0, 0, 0);
    }
}
__device__ __forceinline__ int row32(int reg, int lane) { return (reg & 3) + 8 * (reg >> 2) + 4 * (lane >> 5); }

__device__ __forceinline__ void transpose_item(const float* W, int K, int N, bf16_t* WT, const float* scale, LAS float* scr, int item, int lane) {
    const int nkb = K / 64, kb = item % nkb, nb = item / nkb, k0 = 64 * kb, n0 = 64 * nb;
    const int r = lane >> 4, c4 = lane & 15;
    f32x4 vv[16];
#pragma unroll
    for (int i = 0; i < 16; ++i) vv[i] = *(const f32x4*)(W + (size_t)(k0 + 4 * i + r) * N + n0 + 4 * c4);
    if (scale) {
#pragma unroll
        for (int i = 0; i < 16; ++i) vv[i] = vv[i] * scale[k0 + 4 * i + r];
    }
#pragma unroll
    for (int i = 0; i < 16; ++i) {
        LAS float* d = scr + (4 * i + r) * 65 + 4 * c4;
        d[0] = vv[i][0]; d[1] = vv[i][1]; d[2] = vv[i][2]; d[3] = vv[i][3];
    }
    LDS_WAIT();
    const int cch = lane & 7;
#pragma unroll
    for (int j = 0; j < 8; ++j) { const int n = (lane >> 3) + 8 * j; const LAS float* s = scr + (8 * cch) * 65 + n;
        u32x4 o; o.x = pk2(s[0], s[65]); o.y = pk2(s[2 * 65], s[3 * 65]); o.z = pk2(s[4 * 65], s[5 * 65]); o.w = pk2(s[6 * 65], s[7 * 65]);
        *(u32x4*)(WT + (size_t)(n0 + n) * K + k0 + 8 * cch) = o; }
    LDS_WAIT();
}

struct Args { const float* in[25]; float* out; unsigned char* ws; };

__device__ __forceinline__ void phase_prep(const Args& a, LAS unsigned char* lds) {
    const int tid = opaque_tid(), lane = tid & 63, wave = tid >> 6;
    unsigned char* ws = a.ws;
    {
        LAS float* scr = (LAS float*)(lds + wave * 16640);
        const int gw = blockIdx.x * 8 + wave, NGW = gridDim.x * 8;
        constexpr int I_IN = 32 * 224, I_GLU = 16 * 16, I_BR = 16 * 32, I_OUT = 32 * 32, I_L = I_IN + I_GLU + 3 * I_BR + I_OUT;
        for (int it = gw; it < DEPTH * I_L; it += NGW) {
            const int l = it / I_L; int r = it % I_L;
            if (r < I_IN) { transpose_item(a.in[2] + (size_t)l * DM * NIN, DM, NIN, (bf16_t*)(ws + OFF_WIN) + (size_t)l * NIN * DM, a.in[1] + l * DM, scr, r, lane); continue; } r -= I_IN;
            if (r < I_GLU) { transpose_item(a.in[11] + (size_t)l * WM * WM, WM, WM, (bf16_t*)(ws + OFF_WGLU) + (size_t)l * WM * WM, nullptr, scr, r, lane); continue; } r -= I_GLU;
            if (r < 3 * I_BR) { const int br = r / I_BR; r %= I_BR;
                transpose_item(a.in[22] + ((size_t)l * 3 + br) * WM * DM, WM, DM, (bf16_t*)(ws + OFF_WBR) + ((size_t)l * 3 + br) * DM * WM, nullptr, scr, r, lane); continue; } r -= 3 * I_BR;
            transpose_item(a.in[23] + (size_t)l * DM * DM, DM, DM, (bf16_t*)(ws + OFF_WOUT) + (size_t)l * DM * DM, nullptr, scr, r, lane);
        }
    }
    {
        const float* x = a.in[0]; bf16_t* xb = (bf16_t*)(ws + OFF_XB); u64* ssq = (u64*)(ws + OFF_SSQ);
        for (int row = blockIdx.x * 8 + wave; row < T_TOK; row += gridDim.x * 8) {
            float s = 0.f;
#pragma unroll
            for (int j = 0; j < 8; ++j) {
                const f32x4 v = *(const f32x4*)(x + (size_t)row * DM + 4 * lane + 256 * j);
                s += v[0] * v[0] + v[1] * v[1] + v[2] * v[2] + v[3] * v[3];
                u32x2 w; w.x = pk2(v[0], v[1]); w.y = pk2(v[2], v[3]);
                *(u32x2*)(xb + (size_t)row * DM + 4 * lane + 256 * j) = w;
            }
#pragma unroll
            for (int o = 1; o < 64; o <<= 1) s += __shfl_xor(s, o);
            if (lane == 0) ssq[row] = (u64)(s * 16777216.0f);
        }
    }
    const int gt = blockIdx.x * 512 + tid, NT = gridDim.x * 512;
    { u64* ssq = (u64*)(ws + OFF_SSQ) + T_TOK; for (int i = gt; i < 4 * T_TOK; i += NT) ssq[i] = 0ull; }
    for (int i = gt; i < WM; i += NT) {
        const float* hb = a.in[20]; const float v0 = hb[i], v1 = hb[WM + i], v2 = hb[2 * WM + i], v3 = hb[3 * WM + i];
        const float mx = fmaxf(fmaxf(v0, v1), fmaxf(v2, v3));
        const float e0 = expf(v0 - mx), e1 = expf(v1 - mx), e2 = expf(v2 - mx), e3 = expf(v3 - mx), inv = 1.0f / (e0 + e1 + e2 + e3);
        float* lbs = (float*)(ws + OFF_LBS);
        lbs[i] = 0.f; lbs[WM + i] = e1 * inv; lbs[2 * WM + i] = (e1 + e2) * inv; lbs[3 * WM + i] = (e1 + e2 + e3) * inv;
    }
    for (int i = gt; i < DEPTH * 64 * 64; i += NT) {
        const int l = i >> 12, g = (i >> 6) & 63, p = i & 63;
        const float lre = a.in[3][i], lim = a.in[4][i], step = expf(a.in[5][l * 64 + g]);
        const float mag = expf(lre * step), ang = lim * step;
        const float are = mag * cosf(ang), aim = mag * sinf(ang);
        const float nre = are - 1.0f, nim = aim, den = lre * lre + lim * lim;
        const float cre = (nre * lre + nim * lim) / den, cim = (nim * lre - nre * lim) / den;
        ((float2*)(ws + OFF_S5A))[i] = make_float2(are, aim);
        const float* bre = a.in[6] + (size_t)i * 16; const float* bim = a.in[7] + (size_t)i * 16;
        bf16_t* bt = (bf16_t*)(ws + OFF_S5BT) + ((size_t)(l * 64 + g) * 128) * 16;
        bf16_t* ct = (bf16_t*)(ws + OFF_S5CT) + ((size_t)(l * 64 + g) * 16) * 128;
        const float* cr = a.in[8] + (size_t)(l * 64 + g) * 16 * 64; const float* ci = a.in[9] + (size_t)(l * 64 + g) * 16 * 64;
#pragma unroll 4
        for (int h = 0; h < 16; ++h) {
            const float br_ = bre[h], bi_ = bim[h];
            bt[(size_t)(2 * p) * 16 + h] = f2bf(cre * br_ - cim * bi_);
            bt[(size_t)(2 * p + 1) * 16 + h] = f2bf(cre * bi_ + cim * br_);
            ct[(size_t)h * 128 + 2 * p] = f2bf(cr[h * 64 + p]);
            ct[(size_t)h * 128 + 2 * p + 1] = f2bf(-ci[h * 64 + p]);
        }
    }
    for (int i = gt; i < DEPTH * 16 * 128 * 64; i += NT) {
        const int ii = i & 63, j = (i >> 6) & 127, ln = i >> 13;
        const float v = j < 64 ? a.in[15][(size_t)ln * 4096 + ii * 64 + j] : a.in[17][(size_t)ln * 4096 + ii * 64 + (j - 64)];
        ((bf16_t*)(ws + OFF_RGW))[i] = f2bf(v);
    }
}

__device__ __forceinline__ void s5_item(LAS unsigned char* lds, const bf16_t* Z, bf16_t* Ypre, const float2* abar, const bf16_t* BT, const bf16_t* CT, const float* dvec, int b, int g) {
    const int tid = opaque_tid(), lane = tid & 63, w = __builtin_amdgcn_readfirstlane(tid >> 6);
    const int r = lane & 31, h = lane >> 5;
    const size_t Rb = (size_t)b * SEQ;
    if (w >= 4) {
        const int nt = w - 4;
        const bf16x8 bfrag = *(const bf16x8*)(BT + (size_t)(32 * nt + r) * 16 + 8 * h);
        const bf16_t* zA = Z + (Rb + r) * ZW + g * 16 + 8 * h;
        bf16x8 a0n = *(const bf16x8*)zA, a1n = *(const bf16x8*)(zA + (size_t)32 * ZW);
#pragma unroll 1
        for (int it = 0; it < 66; ++it) {
            if (it < 64) {
                const bf16x8 a0 = a0n, a1 = a1n;
                if (it + 1 < 64) { a0n = *(const bf16x8*)(zA + (size_t)(64 * (it + 1)) * ZW); a1n = *(const bf16x8*)(zA + (size_t)(64 * (it + 1) + 32) * ZW); }
                LAS float* BU = (LAS float*)(lds + (it & 1) * 32768);
                f32x16 acc;
#pragma unroll
                for (int i = 0; i < 16; ++i) acc[i] = 0.f;
                acc = __builtin_amdgcn_mfma_f32_32x32x16_bf16(a0, bfrag, acc, 0, 0, 0);
#pragma unroll
                for (int reg = 0; reg < 16; ++reg) BU[row32(reg, lane) * 128 + 32 * nt + r] = acc[reg];
#pragma unroll
                for (int i = 0; i < 16; ++i) acc[i] = 0.f;
                acc = __builtin_amdgcn_mfma_f32_32x32x16_bf16(a1, bfrag, acc, 0, 0, 0);
#pragma unroll
                for (int reg = 0; reg < 16; ++reg) BU[(32 + row32(reg, lane)) * 128 + 32 * nt + r] = acc[reg];
            }
            __syncthreads();
        }
    } else if (w == 0) {
        const float2 ab = abar[lane];
        float xr = 0.f, xi = 0.f;
        __builtin_amdgcn_s_setprio(3);
#pragma unroll 1
        for (int it = 0; it < 66; ++it) {
            if (it >= 1 && it <= 64) {
                const LAS float* BU = (const LAS float*)(lds + ((it - 1) & 1) * 32768);
                LAS bf16_t* XS = (LAS bf16_t*)(lds + 65536 + ((it - 1) & 1) * 17408);
                f32x2 bb[2][16];
#pragma unroll
                for (int i = 0; i < 16; ++i) bb[0][i] = *(const LAS f32x2*)(BU + i * 128 + 2 * lane);
#pragma unroll
                for (int tb = 0; tb < 4; ++tb) {
                    if (tb < 3) {
#pragma unroll
                        for (int i = 0; i < 16; ++i) bb[(tb + 1) & 1][i] = *(const LAS f32x2*)(BU + (16 * (tb + 1) + i) * 128 + 2 * lane);
                    }
#pragma unroll
                    for (int i = 0; i < 16; ++i) {
                        const f32x2 bv = bb[tb & 1][i];
                        float t1 = __builtin_fmaf(-ab.y, xi, bv.x), t2 = __builtin_fmaf(ab.y, xr, bv.y);
                        asm("" : "+v"(t1)); asm("" : "+v"(t2));
                        const float nr = __builtin_fmaf(ab.x, xr, t1), ni = __builtin_fmaf(ab.x, xi, t2);
                        xr = nr; xi = ni;
                        *(LAS unsigned*)(XS + (16 * tb + i) * 136 + 2 * lane) = pk2(xr, xi);
                    }
                }
            }
            __syncthreads();
        }
        __builtin_amdgcn_s_setprio(0);
    } else {
        const int nty = w == 1 ? 2 : 1, ty0 = w == 1 ? 0 : w;
        bf16x8 cfrag[4];
#pragma unroll
        for (int ks = 0; ks < 4; ++ks) cfrag[ks] = *(const bf16x8*)(CT + (size_t)(lane & 15) * 128 + 32 * ks + 8 * (lane >> 4));
        const float dd = dvec[g * 16 + (lane & 15)];
        const bf16_t* zU = Z + (Rb + (lane >> 4) * 4) * ZW + g * 16 + (lane & 15);
        bf16_t un[2][4];
#pragma unroll
        for (int q = 0; q < 2; ++q)
#pragma unroll
            for (int reg = 0; reg < 4; ++reg) un[q][reg] = (q < nty) ? zU[(size_t)(16 * (ty0 + q) + reg) * ZW] : (bf16_t)0;
#pragma unroll 1
        for (int it = 0; it < 66; ++it) {
            if (it >= 2) {
                const int c = it - 2;
                const LAS bf16_t* XS = (const LAS bf16_t*)(lds + 65536 + (c & 1) * 17408);
                bf16_t uc[2][4];
#pragma unroll
                for (int q = 0; q < 2; ++q)
#pragma unroll
                    for (int reg = 0; reg < 4; ++reg) uc[q][reg] = un[q][reg];
                if (c + 1 < 64) {
#pragma unroll
                    for (int q = 0; q < 2; ++q)
#pragma unroll
                        for (int reg = 0; reg < 4; ++reg) if (q < nty) un[q][reg] = zU[(size_t)(64 * (c + 1) + 16 * (ty0 + q) + reg) * ZW];
                }
#pragma unroll
                for (int q = 0; q < 2; ++q) {
                    if (q < nty) {
                        const int ty = ty0 + q;
                        f32x4 a4 = (f32x4){0.f, 0.f, 0.f, 0.f};
#pragma unroll
                        for (int ks = 0; ks < 4; ++ks) {
                            const bf16x8 av = *(const LAS bf16x8*)(XS + (16 * ty + (lane & 15)) * 136 + 32 * ks + 8 * (lane >> 4));
                            a4 = __builtin_amdgcn_mfma_f32_16x16x32_bf16(av, cfrag[ks], a4, 0, 0, 0);
                        }
#pragma unroll
                        for (int reg = 0; reg < 4; ++reg) {
                            const int t = 16 * ty + (lane >> 4) * 4 + reg, hh = lane & 15;
                            const float y = a4[reg] + dd * bf2f(uc[q][reg]);
                            const float uu = 0.7978845608f * (y + 0.044715f * y * y * y);
                            const float th = 1.0f - 2.0f * __builtin_amdgcn_rcpf(1.0f + __expf(2.0f * uu));
                            Ypre[(Rb + 64 * c + t) * WM + g * 16 + hh] = f2bf(0.5f * y * (1.0f + th));
                        }
                    }
                }
            }
            __syncthreads();
        }
    }
    __syncthreads();
}

__device__ __forceinline__ unsigned flag_ld(const unsigned* p) { return __hip_atomic_load(p, __ATOMIC_RELAXED, __HIP_MEMORY_SCOPE_AGENT); }
struct RgSetup { float cw0, cw1, cw2, cw3, cb, bias, sp8; bf16x8 wfrag[4]; };
__device__ __forceinline__ RgSetup rg_setup(const bf16_t* WgT, const float* convw, const float* convb, const float* b_a, const float* b_x, const float* lam, int n) {
    const int tid = opaque_tid(), lane = tid & 63, w = __builtin_amdgcn_readfirstlane(tid >> 6);
    RgSetup s; const int ch = n * 64 + lane;
    s.cw0 = convw[ch]; s.cw1 = convw[WM + ch]; s.cw2 = convw[2 * WM + ch]; s.cw3 = convw[3 * WM + ch]; s.cb = convb[ch];
    const int nt = w & 3, r = lane & 31, h = lane >> 5;
#pragma unroll
    for (int ks = 0; ks < 4; ++ks) s.wfrag[ks] = *(const bf16x8*)(WgT + (size_t)(32 * nt + r) * 64 + 16 * ks + 8 * h);
    const int chg = n * 64 + ((32 * nt + r) & 63);
    s.bias = nt < 2 ? b_a[chg] : b_x[chg];
    s.sp8 = 8.0f * log1pf(expf(-lam[chg]));
    return s;
}
__device__ __forceinline__ void rg_item(LAS unsigned char* lds, const bf16_t* Z, bf16_t* Yb, const RgSetup st, int seg, int b, int n, float* summ, unsigned* flags, unsigned want) {
    const int tid = opaque_tid(), lane = tid & 63, w = __builtin_amdgcn_readfirstlane(tid >> 6);
    LAS float* XCf = (LAS float*)lds;
    LAS bf16_t* XCb = (LAS bf16_t*)(lds + 16384);
    LAS float* A_ = (LAS float*)(lds + 25600);
    LAS float* M_ = (LAS float*)(lds + 41984);
    LAS float* IX_ = (LAS float*)(lds + 58368);
    LAS bf16_t* HL = (LAS bf16_t*)(lds + 74752);
    LAS bf16_t* AC = (LAS bf16_t*)(lds + 107520);
    LAS float* HIN = (LAS float*)(lds + 140288);
    const int c = lane, oct = w, ch = n * 64 + c;
    const float cw0 = st.cw0, cw1 = st.cw1, cw2 = st.cw2, cw3 = st.cw3, cb = st.cb;
    const int mt = w >> 2, nt = w & 3, r = lane & 31, h = lane >> 5;
    const int cc = (32 * nt + r) & 63;
    const float bias = st.bias, sp8 = st.sp8;
    float hstate = 0.f, aprod = 1.f;
    const int ts = 256 * seg;
    const bf16_t* zx = Z + ((size_t)b * SEQ + ts + 8 * oct) * ZW + 2048 + ch;
    bf16_t xn[11];
#pragma unroll
    for (int i = 0; i < 11; ++i) xn[i] = (ts + 8 * oct - 3 + i >= 0) ? zx[(ptrdiff_t)(i - 3) * ZW] : (bf16_t)0;
    bf16_t sg[32];
    {
        const bf16_t* zs = Z + ((size_t)b * SEQ + ts + 32 * w) * ZW + 3072 + ch;
#pragma unroll
        for (int i = 0; i < 32; ++i) sg[i] = zs[(size_t)i * ZW];
    }
#pragma unroll 1
    for (int tile = 0; tile < 4; ++tile) {
        const int t0 = ts + 64 * tile;
        {
            float xv[11];
#pragma unroll
            for (int i = 0; i < 11; ++i) xv[i] = bf2f(xn[i]);
            if (tile < 3) {
                const bf16_t* zn = zx + (size_t)(64 * (tile + 1)) * ZW;
#pragma unroll
                for (int i = 0; i < 11; ++i) xn[i] = zn[(ptrdiff_t)(i - 3) * ZW];
            }
#pragma unroll
            for (int i = 0; i < 8; ++i) {
                const float xc = cb + cw0 * xv[i] + cw1 * xv[i + 1] + cw2 * xv[i + 2] + cw3 * xv[i + 3];
                const int t = 8 * oct + i;
                XCf[t * 64 + c] = xc; XCb[t * 72 + c] = f2bf(xc);
            }
        }
        __syncthreads();
        {
            f32x16 acc;
#pragma unroll
            for (int i = 0; i < 16; ++i) acc[i] = 0.f;
#pragma unroll
            for (int ks = 0; ks < 4; ++ks) {
                const bf16x8 av = *(const LAS bf16x8*)(XCb + (32 * mt + r) * 72 + 16 * ks + 8 * h);
                acc = __builtin_amdgcn_mfma_f32_32x32x16_bf16(av, st.wfrag[ks], acc, 0, 0, 0);
            }
#pragma unroll
            for (int reg = 0; reg < 16; ++reg) {
                const int t = 32 * mt + row32(reg, lane);
                const float s = sigmoidf_(acc[reg] + bias);
                if (nt < 2) {
                    const float la = -s * sp8; const float av = __expf(la); const float x2 = 2.0f * la;
                    const float m2 = x2 > -0.05f ? -x2 * (1.0f + x2 * (0.5f + x2 * (0.16666667f + x2 * 0.041666667f))) : 1.0f - __expf(x2);
                    float mult = sqrtf(m2); if (t0 + t == 0) mult = 1.0f;
                    A_[t * 64 + cc] = av; M_[t * 64 + cc] = mult;
                } else IX_[t * 64 + cc] = s * XCf[t * 64 + cc];
            }
        }
        __syncthreads();
        if (w == 0) {
#pragma unroll 1
            for (int tb = 0; tb < 4; ++tb) {
                float a_[16], m_[16], x_[16];
#pragma unroll
                for (int i = 0; i < 16; ++i) { const int t = 16 * tb + i; a_[i] = A_[t * 64 + c]; m_[i] = M_[t * 64 + c]; x_[i] = IX_[t * 64 + c]; }
#pragma unroll
                for (int i = 0; i < 16; ++i) {
                    hstate = a_[i] * hstate + m_[i] * x_[i]; aprod *= a_[i];
                    HL[(64 * tile + 16 * tb + i) * 64 + c] = f2bf(hstate); AC[(64 * tile + 16 * tb + i) * 64 + c] = f2bf(aprod);
                }
            }
        }
        __syncthreads();
    }
    const int bn = b * 16 + n;
    if (w == 0) {
        float* sm = summ + ((size_t)(seg * 32 + bn)) * 128;
        __hip_atomic_store(sm + c, aprod, __ATOMIC_RELAXED, __HIP_MEMORY_SCOPE_AGENT);
        __hip_atomic_store(sm + 64 + c, hstate, __ATOMIC_RELAXED, __HIP_MEMORY_SCOPE_AGENT);
        asm volatile("s_waitcnt vmcnt(0)" ::: "memory");
        if (lane == 0) __hip_atomic_store(flags + seg * 32 + bn, want, __ATOMIC_RELAXED, __HIP_MEMORY_SCOPE_AGENT);
        float hin = 0.f;
        if (seg > 0) {
            unsigned spins = 0;
            for (;;) {
                const int ok = (lane < seg) ? (flag_ld(flags + lane * 32 + bn) >= want) : 1;
                if (__all(ok)) break;
                __builtin_amdgcn_s_sleep(2);
                if (++spins > (1u << 22)) break;
            }
#pragma unroll 1
            for (int s0 = 0; s0 < seg; s0 += 8) {
                float at[8], he[8];
#pragma unroll
                for (int q = 0; q < 8; ++q) {
                    const int s2 = (s0 + q < seg) ? s0 + q : seg - 1;
                    float* p = summ + ((size_t)(s2 * 32 + bn)) * 128;
                    at[q] = __hip_atomic_load(p + c, __ATOMIC_RELAXED, __HIP_MEMORY_SCOPE_AGENT); he[q] = __hip_atomic_load(p + 64 + c, __ATOMIC_RELAXED, __HIP_MEMORY_SCOPE_AGENT);
                }
#pragma unroll
                for (int q = 0; q < 8; ++q) if (s0 + q < seg) hin = at[q] * hin + he[q];
            }
        }
        HIN[c] = hin;
    }
    __syncthreads();
    {
        const float hin = HIN[c];
        bf16_t* yo = Yb + ((size_t)b * SEQ + ts + 32 * w) * WM + ch;
#pragma unroll
        for (int i = 0; i < 32; ++i) {
            const int t = 32 * w + i;
            yo[(size_t)i * WM] = f2bf((bf2f(HL[t * 64 + c]) + bf2f(AC[t * 64 + c]) * hin) * bf2f(sg[i]));
        }
    }
    __syncthreads();
}

__device__ __forceinline__ void hg_item(LAS unsigned char* lds, const bf16_t* Z, bf16_t* Yc, const float* normw, int b, int hd, int seg,
                                        float* OL, bf16_t* QH, float* USEG, float* DSEG, unsigned* flags, unsigned want) {
    const int tid = opaque_tid(), lane = tid & 63, w = __builtin_amdgcn_readfirstlane(tid >> 6);
    LAS float* Of = (LAS float*)lds;
    LAS bf16_t* QT = (LAS bf16_t*)(lds + 32768);
    LAS bf16_t* KT = (LAS bf16_t*)(lds + 50176);
    LAS bf16_t* KTT = (LAS bf16_t*)(lds + 67584);
    LAS bf16_t* VT = (LAS bf16_t*)(lds + 86016);
    LAS bf16_t* PP = (LAS bf16_t*)(lds + 104448);
    LAS bf16_t* ST = (LAS bf16_t*)(lds + 113664);
    LAS float* TOT = (LAS float*)(lds + 148480);
    LAS float* E1 = (LAS float*)(lds + 152576);
    LAS float* E2 = (LAS float*)(lds + 153088);
    const int t_ = tid >> 3, cg_ = (tid & 7) * 16;
    const int kp = lane;
    const int kt = w >> 1, vt0 = 2 * (w & 1);
    const int mt = w >> 2, vt = w & 3;
    const int bh = b * 8 + hd, item = seg * 16 + bh;
    const size_t Rs = (size_t)b * SEQ + 512 * seg;
    f32x16 S0, S1;
#pragma unroll
    for (int i = 0; i < 16; ++i) { S0[i] = 0.f; S1[i] = 0.f; }
    float gacc0 = 0.f, gacc1 = 0.f;
    {
    const bf16_t* zc0 = Z + (Rs + 8 * w) * ZW + hd * 128 + 2 * kp;
    unsigned nq[8], nk[8], ng[8], nv[8];
#pragma unroll
    for (int i = 0; i < 8; ++i) { const bf16_t* p = zc0 + (size_t)i * ZW; nq[i] = *(const unsigned*)(p + 4096); ng[i] = *(const unsigned*)(p + 5120); nk[i] = *(const unsigned*)(p + 6144); nv[i] = *(const unsigned*)(p + 7168); }
#pragma unroll 1
    for (int c = 0; c < 8; ++c) {
        const size_t R0 = Rs + 64 * c;
        unsigned q2[8], k2[8], v2[8]; float G0[8], G1[8];
        {
            float r0 = 0.f, r1 = 0.f;
#pragma unroll
            for (int i = 0; i < 8; ++i) { q2[i] = nq[i]; k2[i] = nk[i]; v2[i] = nv[i]; r0 += bflo(ng[i]); r1 += bfhi(ng[i]); G0[i] = r0; G1[i] = r1; }
            *(LAS f32x2*)(TOT + w * 128 + 2 * kp) = (f32x2){r0, r1};
        }
        if (c + 1 < 8) {
            const bf16_t* zn = zc0 + (size_t)(64 * (c + 1)) * ZW;
#pragma unroll
            for (int i = 0; i < 8; ++i) { const bf16_t* p = zn + (size_t)i * ZW; nq[i] = *(const unsigned*)(p + 4096); ng[i] = *(const unsigned*)(p + 5120); nk[i] = *(const unsigned*)(p + 6144); nv[i] = *(const unsigned*)(p + 7168); }
        }
        __syncthreads();
        {
            float off0 = 0.f, off1 = 0.f, gm0 = 0.f, gm1 = 0.f, gl0 = 0.f, gl1 = 0.f;
#pragma unroll
            for (int s = 0; s < 8; ++s) {
                const f32x2 tv = *(const LAS f32x2*)(TOT + s * 128 + 2 * kp);
                if (s < w) { off0 += tv.x; off1 += tv.y; }
                if (s < 4) { gm0 += tv.x; gm1 += tv.y; }
                gl0 += tv.x; gl1 += tv.y;
            }
            float ka[8], kb[8];
            bf16_t* qh = QH + (R0 + 8 * w) * WM + hd * 128 + 2 * kp;
#pragma unroll
            for (int i = 0; i < 8; ++i) {
                const float g0 = G0[i] + off0, g1 = G1[i] + off1;
                const float d0 = g0 - gm0, d1 = g1 - gm1;
                const float qf0 = bflo(q2[i]), qf1 = bfhi(q2[i]);
                const float qa = qf0 * __expf(fminf(d0, 80.f)), qb = qf1 * __expf(fminf(d1, 80.f));
                ka[i] = bflo(k2[i]) * __expf(fminf(-d0, 80.f)); kb[i] = bfhi(k2[i]) * __expf(fminf(-d1, 80.f));
                *(LAS unsigned*)(QT + (8 * w + i) * 136 + 2 * kp) = pk2(qa, qb);
                *(LAS unsigned*)(KT + (8 * w + i) * 136 + 2 * kp) = pk2(ka[i], kb[i]);
                *(unsigned*)(qh + (size_t)i * WM) = pk2(qf0 * __expf(g0 + gacc0), qf1 * __expf(g1 + gacc1));
            }
            gacc0 += gl0; gacc1 += gl1;
            u32x4 wa, wb;
            wa.x = pk2(ka[0], ka[1]); wa.y = pk2(ka[2], ka[3]); wa.z = pk2(ka[4], ka[5]); wa.w = pk2(ka[6], ka[7]);
            wb.x = pk2(kb[0], kb[1]); wb.y = pk2(kb[2], kb[3]); wb.z = pk2(kb[4], kb[5]); wb.w = pk2(kb[6], kb[7]);
            *(LAS u32x4*)(KTT + (2 * kp) * 72 + 8 * w) = wa; *(LAS u32x4*)(KTT + (2 * kp + 1) * 72 + 8 * w) = wb;
            wa.x = (v2[0] & 0xffffu) | (v2[1] << 16); wa.y = (v2[2] & 0xffffu) | (v2[3] << 16); wa.z = (v2[4] & 0xffffu) | (v2[5] << 16); wa.w = (v2[6] & 0xffffu) | (v2[7] << 16);
            wb.x = (v2[0] >> 16) | (v2[1] & 0xffff0000u); wb.y = (v2[2] >> 16) | (v2[3] & 0xffff0000u); wb.z = (v2[4] >> 16) | (v2[5] & 0xffff0000u); wb.w = (v2[6] >> 16) | (v2[7] & 0xffff0000u);
            *(LAS u32x4*)(VT + (2 * kp) * 72 + 8 * w) = wa; *(LAS u32x4*)(VT + (2 * kp + 1) * 72 + 8 * w) = wb;
            if (w == 0) { *(LAS f32x2*)(E1 + 2 * kp) = (f32x2){__expf(gm0), __expf(gm1)}; *(LAS f32x2*)(E2 + 2 * kp) = (f32x2){__expf(gl0 - gm0), __expf(gl1 - gm1)}; }
        }
        __syncthreads();
        {
            if (w < 3) {
                const int pm_ = w == 0 ? 0 : 1, ps_ = w == 2 ? 1 : 0;
                f32x16 acc;
#pragma unroll
                for (int i = 0; i < 16; ++i) acc[i] = 0.f;
                mma32(acc, QT + 32 * pm_ * 136, 136, KT + 32 * ps_ * 136, 136, 128, lane);
#pragma unroll
                for (int reg = 0; reg < 16; ++reg) { const int t = 32 * pm_ + row32(reg, lane), s = 32 * ps_ + (lane & 31);
                    PP[t * 72 + s] = f2bf(s <= t ? acc[reg] : 0.f); }
            } else if (w == 3) {
#pragma unroll
                for (int reg = 0; reg < 16; ++reg) PP[row32(reg, lane) * 72 + 32 + (lane & 31)] = 0;
            }
#pragma unroll
            for (int i = 0; i < 4; ++i) {
                const int kk0 = 32 * kt + 8 * i + 4 * (lane >> 5);
                const f32x4 e = *(const LAS f32x4*)(E1 + kk0);
#pragma unroll
                for (int j = 0; j < 4; ++j) { S0[4 * i + j] *= e[j]; S1[4 * i + j] *= e[j]; }
                u32x2 a0, a1; a0.x = pk2(S0[4 * i], S0[4 * i + 1]); a0.y = pk2(S0[4 * i + 2], S0[4 * i + 3]); a1.x = pk2(S1[4 * i], S1[4 * i + 1]); a1.y = pk2(S1[4 * i + 2], S1[4 * i + 3]);
                *(LAS u32x2*)(ST + (32 * vt0 + (lane & 31)) * 136 + kk0) = a0;
                *(LAS u32x2*)(ST + (32 * (vt0 + 1) + (lane & 31)) * 136 + kk0) = a1;
            }
        }
        __syncthreads();
        {
            f32x16 acc;
#pragma unroll
            for (int i = 0; i < 16; ++i) acc[i] = 0.f;
            mma32(acc, QT + 32 * mt * 136, 136, ST + 32 * vt * 136, 136, 128, lane);
            mma32(acc, PP + 32 * mt * 72, 72, VT + 32 * vt * 72, 72, 64, lane);
            float* ol = OL + (R0 + 32 * mt) * WM + hd * 128 + 32 * vt + (lane & 31);
#pragma unroll
            for (int reg = 0; reg < 16; ++reg) ol[(size_t)row32(reg, lane) * WM] = acc[reg];
            mma32(S0, KTT + 32 * kt * 72, 72, VT + 32 * vt0 * 72, 72, 64, lane);
            mma32(S1, KTT + 32 * kt * 72, 72, VT + 32 * (vt0 + 1) * 72, 72, 64, lane);
#pragma unroll
            for (int i = 0; i < 4; ++i) {
                const f32x4 e = *(const LAS f32x4*)(E2 + 32 * kt + 8 * i + 4 * (lane >> 5));
#pragma unroll
                for (int j = 0; j < 4; ++j) { S0[4 * i + j] *= e[j]; S1[4 * i + j] *= e[j]; }
            }
        }
    }
    }
    {
        float* us = USEG + (size_t)item * 16384 + (size_t)(32 * kt) * 128 + 32 * vt0 + (lane & 31);
#pragma unroll
        for (int reg = 0; reg < 16; ++reg) { us[row32(reg, lane) * 128] = S0[reg]; us[row32(reg, lane) * 128 + 32] = S1[reg]; }
        if (w == 0) { DSEG[item * 128 + 2 * kp] = __expf(gacc0); DSEG[item * 128 + 2 * kp + 1] = __expf(gacc1); }
        asm volatile("s_waitcnt vmcnt(0)" ::: "memory");
        __syncthreads();
        if (tid == 0) {
            __builtin_amdgcn_fence(__ATOMIC_RELEASE, "agent");
            asm volatile("s_waitcnt vmcnt(0)" ::: "memory");
            __hip_atomic_store(flags + item, want, __ATOMIC_RELAXED, __HIP_MEMORY_SCOPE_AGENT);
        }
        if (w == 0) {
            if (seg > 0) {
                unsigned spins = 0;
                for (;;) {
                    const int ok = (lane < seg) ? (flag_ld(flags + lane * 16 + bh) >= want) : 1;
                    if (__all(ok)) break;
                    __builtin_amdgcn_s_sleep(2);
                    if (++spins > (1u << 22)) break;
                }
            }
            __builtin_amdgcn_fence(__ATOMIC_ACQUIRE, "agent");
            asm volatile("s_waitcnt vmcnt(0)" ::: "memory");
        }
        __syncthreads();
    }
    {
#pragma unroll
        for (int i = 0; i < 16; ++i) { S0[i] = 0.f; S1[i] = 0.f; }
        if (seg > 0) {
            float dn[16], u0n[16], u1n[16];
            {
                const float* us = USEG + (size_t)bh * 16384 + (size_t)(32 * kt) * 128 + 32 * vt0 + (lane & 31);
                const float* ds = DSEG + bh * 128 + 32 * kt;
#pragma unroll
                for (int reg = 0; reg < 16; ++reg) { dn[reg] = ds[row32(reg, lane)]; u0n[reg] = us[row32(reg, lane) * 128]; u1n[reg] = us[row32(reg, lane) * 128 + 32]; }
            }
#pragma unroll 1
            for (int s2 = 0; s2 < seg; ++s2) {
                float dc[16], u0c[16], u1c[16];
#pragma unroll
                for (int reg = 0; reg < 16; ++reg) { dc[reg] = dn[reg]; u0c[reg] = u0n[reg]; u1c[reg] = u1n[reg]; }
                if (s2 + 1 < seg) {
                    const int it2 = (s2 + 1) * 16 + bh;
                    const float* us = USEG + (size_t)it2 * 16384 + (size_t)(32 * kt) * 128 + 32 * vt0 + (lane & 31);
                    const float* ds = DSEG + it2 * 128 + 32 * kt;
#pragma unroll
                    for (int reg = 0; reg < 16; ++reg) { dn[reg] = ds[row32(reg, lane)]; u0n[reg] = us[row32(reg, lane) * 128]; u1n[reg] = us[row32(reg, lane) * 128 + 32]; }
                }
#pragma unroll
                for (int reg = 0; reg < 16; ++reg) { S0[reg] = dc[reg] * S0[reg] + u0c[reg]; S1[reg] = dc[reg] * S1[reg] + u1c[reg]; }
            }
        }
#pragma unroll
        for (int i = 0; i < 4; ++i) {
            const int kk0 = 32 * kt + 8 * i + 4 * (lane >> 5);
            u32x2 a0, a1; a0.x = pk2(S0[4 * i], S0[4 * i + 1]); a0.y = pk2(S0[4 * i + 2], S0[4 * i + 3]); a1.x = pk2(S1[4 * i], S1[4 * i + 1]); a1.y = pk2(S1[4 * i + 2], S1[4 * i + 3]);
            *(LAS u32x2*)(ST + (32 * vt0 + (lane & 31)) * 136 + kk0) = a0;
            *(LAS u32x2*)(ST + (32 * (vt0 + 1) + (lane & 31)) * 136 + kk0) = a1;
        }
    }
    {
        float nw[16];
#pragma unroll
        for (int i = 0; i < 16; ++i) nw[i] = normw[hd * 128 + cg_ + i];
        const bf16_t* qr = QH + (Rs + t_) * WM + hd * 128 + cg_;
        const bf16_t* zr = Z + (Rs + t_) * ZW + 8192 + hd * 128 + cg_;
        u32x4 h0 = *(const u32x4*)qr, h1 = *(const u32x4*)(qr + 8);
        u32x4 s0 = *(const u32x4*)zr, s1 = *(const u32x4*)(zr + 8);
        const float* ol0 = OL + (Rs + 32 * mt) * WM + hd * 128 + 32 * vt + (lane & 31);
        float oln[16];
#pragma unroll
        for (int reg = 0; reg < 16; ++reg) oln[reg] = ol0[(size_t)row32(reg, lane) * WM];
#pragma unroll 1
        for (int c = 0; c < 8; ++c) {
            const size_t R0 = Rs + 64 * c;
            *(LAS u32x4*)(QT + t_ * 136 + cg_) = h0; *(LAS u32x4*)(QT + t_ * 136 + cg_ + 8) = h1;
            const u32x4 sc0 = s0, sc1 = s1;
            float olv[16];
#pragma unroll
            for (int reg = 0; reg < 16; ++reg) olv[reg] = oln[reg];
            if (c + 1 < 8) {
                h0 = *(const u32x4*)(qr + (size_t)(64 * (c + 1)) * WM); h1 = *(const u32x4*)(qr + (size_t)(64 * (c + 1)) * WM + 8);
                s0 = *(const u32x4*)(zr + (size_t)(64 * (c + 1)) * ZW); s1 = *(const u32x4*)(zr + (size_t)(64 * (c + 1)) * ZW + 8);
#pragma unroll
                for (int reg = 0; reg < 16; ++reg) oln[reg] = ol0[(size_t)(64 * (c + 1) + row32(reg, lane)) * WM];
            }
            __syncthreads();
            {
                f32x16 acc;
#pragma unroll
                for (int i = 0; i < 16; ++i) acc[i] = olv[i];
                mma32(acc, QT + 32 * mt * 136, 136, ST + 32 * vt * 136, 136, 128, lane);
#pragma unroll
                for (int reg = 0; reg < 16; ++reg) Of[(32 * mt + row32(reg, lane)) * 128 + 32 * vt + (lane & 31)] = acc[reg];
            }
            __syncthreads();
            {
                float o[16]; float ss = 0.f;
#pragma unroll
                for (int i = 0; i < 4; ++i) { const f32x4 v = *(const LAS f32x4*)(Of + t_ * 128 + cg_ + 4 * i); o[4 * i] = v[0]; o[4 * i + 1] = v[1]; o[4 * i + 2] = v[2]; o[4 * i + 3] = v[3]; }
#pragma unroll
                for (int i = 0; i < 16; ++i) ss += o[i] * o[i];
                ss += __shfl_xor(ss, 1); ss += __shfl_xor(ss, 2); ss += __shfl_xor(ss, 4);
                const float rs = rsqrtf(ss * (1.0f / 128.0f) + EPS);
#pragma unroll
                for (int j = 0; j < 4; ++j) {
                    o[2 * j] *= rs * nw[2 * j] * bflo(sc0[j]); o[2 * j + 1] *= rs * nw[2 * j + 1] * bfhi(sc0[j]);
                    o[8 + 2 * j] *= rs * nw[8 + 2 * j] * bflo(sc1[j]); o[8 + 2 * j + 1] *= rs * nw[8 + 2 * j + 1] * bfhi(sc1[j]);
                }
                u32x4 w0, w1;
                w0.x = pk2(o[0], o[1]); w0.y = pk2(o[2], o[3]); w0.z = pk2(o[4], o[5]); w0.w = pk2(o[6], o[7]);
                w1.x = pk2(o[8], o[9]); w1.y = pk2(o[10], o[11]); w1.z = pk2(o[12], o[13]); w1.w = pk2(o[14], o[15]);
                bf16_t* yp = Yc + (R0 + t_) * WM + hd * 128 + cg_;
                *(u32x4*)yp = w0; *(u32x4*)(yp + 8) = w1;
            }
        }
    }
    __syncthreads();
}

#define XB_TMO      128
#define XB_XCNT(j)  (256  + 64 * (j))
#define XB_XSUB(j)  (1280 + 64 * (j))
#define XB_XGEN(j)  (2304 + 64 * (j))
#define XB_TOP      3328
#define XB_TOPGEN   3392
#define XCD_BAR_WORDS 3456
#define XB_SPIN_CAP (1u << 22)
__device__ __forceinline__ unsigned xb_ld(unsigned* p)              { return __hip_atomic_load(p, __ATOMIC_RELAXED, __HIP_MEMORY_SCOPE_AGENT); }
__device__ __forceinline__ unsigned xb_add(unsigned* p, unsigned v) { return __hip_atomic_fetch_add(p, v, __ATOMIC_RELAXED, __HIP_MEMORY_SCOPE_AGENT); }
__device__ __forceinline__ unsigned xb_xcc_id() { return (unsigned)__builtin_amdgcn_s_getreg((3 << 11) | 20) & 0xFu; }
#define XB_SPIN(cond, bar) do { unsigned _sp = 0; while (cond) { __builtin_amdgcn_s_sleep(1); \
    if ((++_sp & 255u) == 0u) { if (xb_ld(&(bar)[XB_TMO])) break; if (_sp > XB_SPIN_CAP) { atomicAdd(&(bar)[XB_TMO], 1u); break; } } } } while (0)
struct XcdBarrier { unsigned* bar; unsigned x; volatile LAS unsigned* st; };
__device__ __forceinline__ XcdBarrier xcd_barrier_post(unsigned* bar, volatile LAS unsigned* st) {
    XcdBarrier b; b.bar = bar; b.x = xb_xcc_id(); b.st = st;
    if (threadIdx.x == 0) (void)xb_add(&bar[XB_XCNT(b.x)], 1u);
    return b;
}
__device__ __forceinline__ void xcd_barrier_complete(unsigned* bar, unsigned x, unsigned& nloc, unsigned& nx) {
    const unsigned G = gridDim.x * gridDim.y * gridDim.z;
    unsigned sum, cnt, mine, sp = 0u;
    for (;;) {
        sum = 0u; cnt = 0u; mine = 0u;
#pragma unroll
        for (unsigned j = 0; j < 16; ++j) { const unsigned c = xb_ld(&bar[XB_XCNT(j)]); sum += c; cnt += (c > 0u) ? 1u : 0u; mine = (j == x) ? c : mine; }
        if (sum == G) break;
        __builtin_amdgcn_s_sleep(1);
        if ((++sp & 255u) == 0u) { if (xb_ld(&bar[XB_TMO])) break; if (sp > XB_SPIN_CAP) { atomicAdd(&bar[XB_TMO], 1u); break; } }
    }
    nloc = mine > 0u ? mine : 1u; nx = cnt > 0u ? cnt : 1u;
}
__device__ __forceinline__ void xcd_barrier(const XcdBarrier& b) {
    asm volatile("s_waitcnt vmcnt(0)" ::: "memory");
    __syncthreads();
    if (threadIdx.x == 0) {
        unsigned* bar = b.bar;
        __builtin_amdgcn_s_waitcnt(0);
        unsigned nloc = b.st[0], nx = b.st[1];
        if (nloc == 0u) { xcd_barrier_complete(bar, b.x, nloc, nx); b.st[0] = nloc; b.st[1] = nx; }
        const unsigned old = xb_add(&bar[XB_XSUB(b.x)], 1u);
        const unsigned gen = old / nloc;
        if (old + 1u == (gen + 1u) * nloc) {
            __builtin_amdgcn_fence(__ATOMIC_RELEASE, "agent");
            asm volatile("s_waitcnt vmcnt(0)" ::: "memory");
            const unsigned og = xb_add(&bar[XB_TOP], 1u);
            const unsigned tg = og / nx;
            if (og + 1u == (tg + 1u) * nx) xb_add(&bar[XB_TOPGEN], 1u);
            else XB_SPIN(xb_ld(&bar[XB_TOPGEN]) == tg, bar);
            __builtin_amdgcn_fence(__ATOMIC_ACQUIRE, "agent");
            xb_add(&bar[XB_XGEN(b.x)], 1u);
            asm volatile("s_waitcnt vmcnt(0)" ::: "memory");
        } else {
            XB_SPIN(xb_ld(&bar[XB_XGEN(b.x)]) == gen, bar);
            __builtin_amdgcn_fence(__ATOMIC_ACQUIRE, "agent");
            asm volatile("s_waitcnt vmcnt(0)" ::: "memory");
        }
    }
    __syncthreads();
}

extern "C" __global__ void __launch_bounds__(512, 2) mk_fwd(Args a) {
    extern __shared__ __attribute__((aligned(16))) unsigned char shm[];
    LAS unsigned char* lds = (LAS unsigned char*)shm;
    cg::grid_group grid = cg::this_grid();
    unsigned char* ws = a.ws;
    volatile LAS unsigned* xst = (volatile LAS unsigned*)(lds + LDS_BYTES - 16);
    if (threadIdx.x == 0) { xst[0] = 0u; xst[1] = 0u; }
    __syncthreads();
    const XcdBarrier xb = xcd_barrier_post((unsigned*)(ws + OFF_BAR), xst);
    const int G = gridDim.x, bid = blockIdx.x;
    u64* ssq = (u64*)(ws + OFF_SSQ);
    bf16_t* Xb = (bf16_t*)(ws + OFF_XB);
    bf16_t* Z = (bf16_t*)(ws + OFF_Z);
    bf16_t* Ypre = (bf16_t*)(ws + OFF_YPRE);
    bf16_t* Y3 = (bf16_t*)(ws + OFF_Y3);
    bf16_t* Mrg = (bf16_t*)(ws + OFF_MRG);

    phase_prep(a, lds);
    grid.sync();

#pragma unroll 1
    for (int l = 0; l < DEPTH; ++l) {
        {
            pg8::Gemm g{Xb, (const bf16_t*)(ws + OFF_WIN) + (size_t)l * NIN * DM, T_TOK, NIN, DM, 0, 0};
            pg8::StaticOrder S; S.init(T_TOK, NIN, G, bid);
            EpiZ E{Z, ssq + l * T_TOK, (const float*)(ws + OFF_LBS) + l * WM};
            pg8::gemm_phase(lds, g, S, E);
        }
        GSYNC();
        {
            {
                const int bn0 = bid & 31, n0 = bn0 & 15;
                const RgSetup st = rg_setup((const bf16_t*)(ws + OFF_RGW) + (size_t)(l * 16 + n0) * 8192, a.in[13] + l * 4 * WM, a.in[14] + l * WM,
                                            a.in[16] + l * WM, a.in[18] + l * WM, a.in[19] + l * WM, n0);
#pragma unroll 1
                for (int j = 0; j < 3; ++j) {
                    int it;
                    if (bid < 128) { if (j > 0) break; it = bid; } else it = 128 + (bid - 128) + 128 * j;
                    const int seg = it >> 5, bn = it & 31, b = bn >> 4, n = bn & 15;
                    rg_item(lds, Z, Y3 + (size_t)T_TOK * WM, st, seg, b, n, (float*)(ws + OFF_RGS), (unsigned*)(ws + OFF_FLG), (unsigned)(l + 1));
                }
            }
            if (bid < 128) {
                const int b = bid >> 6, g = bid & 63;
                s5_item(lds, Z, Ypre, (const float2*)(ws + OFF_S5A) + (l * 64 + g) * 64, (const bf16_t*)(ws + OFF_S5BT) + (size_t)(l * 64 + g) * 2048,
                        (const bf16_t*)(ws + OFF_S5CT) + (size_t)(l * 64 + g) * 2048, a.in[10] + l * WM, b, g);
                {
                    pg8::Gemm g2{Ypre, (const bf16_t*)(ws + OFF_WGLU) + (size_t)l * WM * WM, T_TOK, WM, WM, 0, 0};
                    pg8::StaticOrder S; S.init(T_TOK, WM, 128, bid);
                    pg8::Unit u0; S.next(0, u0);
                    unsigned* s5cnt = (unsigned*)(ws + OFF_FLG) + 2048;
                    asm volatile("s_waitcnt vmcnt(0)" ::: "memory");
                    __syncthreads();
                    if (threadIdx.x == 0) {
                        __builtin_amdgcn_fence(__ATOMIC_RELEASE, "agent");
                        asm volatile("s_waitcnt vmcnt(0)" ::: "memory");
                        __hip_atomic_fetch_add(s5cnt + 64 * b, 1u, __ATOMIC_RELAXED, __HIP_MEMORY_SCOPE_AGENT);
                        unsigned spins = 0;
                        while (__hip_atomic_load(s5cnt + 64 * (u0.pm >> 4), __ATOMIC_RELAXED, __HIP_MEMORY_SCOPE_AGENT) < 64u * (unsigned)(l + 1)) {
                            __builtin_amdgcn_s_sleep(2); if (++spins > (1u << 22)) break; }
                        __builtin_amdgcn_fence(__ATOMIC_ACQUIRE, "agent");
                        asm volatile("s_waitcnt vmcnt(0)" ::: "memory");
                    }
                    __syncthreads();
                    EpiGlu E{Ypre, Z, a.in[12] + l * WM, Y3};
                    pg8::gemm_phase(lds, g2, S, E);
                }
            } else {
                const int i = bid - 128, seg = i >> 4, bh = i & 15;
                hg_item(lds, Z, Y3 + (size_t)2 * T_TOK * WM, a.in[21] + l * WM, bh >> 3, bh & 7, seg, (float*)(ws + OFF_OL), (bf16_t*)(ws + OFF_QH),
                        (float*)(ws + OFF_USEG), (float*)(ws + OFF_DSEG), (unsigned*)(ws + OFF_FLG) + 1024, (unsigned)(l + 1));
            }
        }
        GSYNC();
        {
            pg8::Gemm g{Y3, (const bf16_t*)(ws + OFF_WBR) + (size_t)l * 3 * DM * WM, T_TOK, DM, WM, (size_t)T_TOK * WM * 2, (size_t)DM * WM * 2};
            pg8::Order3 S; S.init(T_TOK, DM, G, bid);
            EpiBr E{Z, Mrg};
            pg8::gemm_phase(lds, g, S, E);
        }
        GSYNC();
        {
            pg8::Gemm g{Mrg, (const bf16_t*)(ws + OFF_WOUT) + (size_t)l * DM * DM, T_TOK, DM, DM, 0, 0};
            pg8::StaticOrder S; S.init(T_TOK, DM, G, bid);
            EpiOut E{l == 0 ? a.in[0] : nullptr, Xb, ssq + (l + 1) * T_TOK};
            pg8::gemm_phase(lds, g, S, E);
        }
        GSYNC();
    }
    {
        const int tid = opaque_tid(), lane = tid & 63, wave = tid >> 6;
        const float* fw = a.in[24]; const u64* sq = ssq + 4 * T_TOK;
        for (int row = bid * 8 + wave; row < T_TOK; row += G * 8) {
            const float rs = ssq_rstd(sq + row);
#pragma unroll
            for (int j = 0; j < 8; ++j) {
                const int col = 4 * lane + 256 * j;
                const u32x2 xw = *(const u32x2*)(Xb + (size_t)row * DM + col); const f32x4 v = (f32x4){bflo(xw.x), bfhi(xw.x), bflo(xw.y), bfhi(xw.y)}; const f32x4 wv = *(const f32x4*)(fw + col);
                *(f32x4*)(a.out + (size_t)row * DM + col) = v * rs * wv;
            }
        }
    }
}

extern "C" void kernel_launch(void* const* d_in, const int* in_sizes, int n_in, void* d_out, int out_size, void* d_ws, size_t ws_size, hipStream_t stream) {
    static int grid = 0;
    if (grid == 0) {
        if (n_in != 25 || ws_size < WS_END) { fprintf(stderr, "kernel_launch: unexpected n_in %d or ws_size %zu (need %zu)\n", n_in, ws_size, (size_t)WS_END); grid = -1; return; }
        int dev = 0, cus = 0, per = 0;
        (void)hipGetDevice(&dev); (void)hipDeviceGetAttribute(&cus, hipDeviceAttributeMultiprocessorCount, dev);
        if (hipFuncSetAttribute((const void*)mk_fwd, hipFuncAttributeMaxDynamicSharedMemorySize, LDS_BYTES) != hipSuccess) fprintf(stderr, "kernel_launch: hipFuncSetAttribute failed\n");
        (void)hipOccupancyMaxActiveBlocksPerMultiprocessor(&per, (const void*)mk_fwd, 512, LDS_BYTES);
        (void)hipGetLastError();
        grid = cus > 0 ? cus : 256;
        if (grid > 256) grid = 256;
    }
    if (grid < 0) return;
    (void)hipMemsetAsync((unsigned char*)d_ws + OFF_BAR, 0, 32768, stream);
    Args a{};
    for (int i = 0; i < 25; ++i) a.in[i] = (const float*)d_in[i];
    a.out = (float*)d_out; a.ws = (unsigned char*)d_ws;
    void* args[] = {&a};
    hipError_t e = hipLaunchCooperativeKernel((void*)mk_fwd, dim3(grid), dim3(512), args, LDS_BYTES, stream);
    if (e != hipSuccess) fprintf(stderr, "cooperative launch failed: %s (grid %d)\n", hipGetErrorString(e), grid);
}
```

```cpp
#include <hip/hip_runtime.h>
#include <hip/hip_cooperative_groups.h>
#include <cstdio>
#include <cstdint>
namespace cg = cooperative_groups;
#define GSYNC() xcd_barrier(xb)

#define LAS __attribute__((address_space(3)))
typedef unsigned short bf16_t;
typedef short bf16x8 __attribute__((ext_vector_type(8)));
typedef float f32x4 __attribute__((ext_vector_type(4)));
typedef float f32x16 __attribute__((ext_vector_type(16)));
typedef unsigned u32x4 __attribute__((ext_vector_type(4)));
typedef unsigned u32x2 __attribute__((ext_vector_type(2)));
typedef unsigned long long u64;
typedef float f32x2 __attribute__((ext_vector_type(2)));
__device__ __forceinline__ float ssq_rstd(const u64* p) { return rsqrtf((float)(*p) * (1.0f / (16777216.0f * 2048.0f)) + 1e-6f); }

constexpr int T_TOK = 8192, SEQ = 4096, DM = 2048, WM = 1024, NIN = 14336, DEPTH = 4;
constexpr int ZW = 15360;
constexpr float EPS = 1e-6f;
constexpr int LDS_BYTES = 163840;

constexpr size_t OFF_SSQ = 0;
constexpr size_t OFF_LBS = 327680;
constexpr size_t OFF_S5A = 344064;
constexpr size_t OFF_S5BT = 475136;
constexpr size_t OFF_S5CT = 1523712;
constexpr size_t OFF_RGW = 2572288;
constexpr size_t OFF_BAR = 3670016;
constexpr size_t OFF_WIN = 4194304;
constexpr size_t OFF_WGLU = OFF_WIN + 234881024ull;
constexpr size_t OFF_WBR = OFF_WGLU + 8388608ull;
constexpr size_t OFF_WOUT = OFF_WBR + 50331648ull;
constexpr size_t OFF_X = OFF_WOUT + 33554432ull;
constexpr size_t OFF_XB = OFF_X + 67108864ull;
constexpr size_t OFF_Z = OFF_XB + 33554432ull;
constexpr size_t OFF_YPRE = OFF_Z + 251658240ull;
constexpr size_t OFF_Y3 = OFF_YPRE + 16777216ull;
constexpr size_t OFF_MRG = OFF_Y3 + 50331648ull;
constexpr size_t OFF_RGS = OFF_MRG + 33554432ull;
constexpr size_t OFF_OL = OFF_RGS + 524288ull;
constexpr size_t OFF_QH = OFF_OL + 33554432ull;
constexpr size_t OFF_USEG = OFF_QH + 16777216ull;
constexpr size_t OFF_DSEG = OFF_USEG + 8388608ull;
constexpr size_t WS_END = OFF_DSEG + 65536ull;
constexpr size_t OFF_FLG = OFF_BAR + 16384;

__device__ __forceinline__ unsigned pk2(float lo, float hi) { unsigned r; asm("v_cvt_pk_bf16_f32 %0, %1, %2" : "=v"(r) : "v"(lo), "v"(hi)); return r; }
__device__ __forceinline__ unsigned pk2t(float lo, float hi) { unsigned r; asm("s_nop 1\n\tv_cvt_pk_bf16_f32 %0, %1, %2" : "=v"(r) : "v"(lo), "v"(hi)); return r; }
__device__ __forceinline__ bf16_t f2bf(float f) { return (bf16_t)(pk2(f, 0.f) & 0xffffu); }
__device__ __forceinline__ float bf2f(bf16_t b) { return __uint_as_float(((unsigned)b) << 16); }
__device__ __forceinline__ float bflo(unsigned w) { return __uint_as_float(w << 16); }
__device__ __forceinline__ float bfhi(unsigned w) { return __uint_as_float(w & 0xffff0000u); }
__device__ __forceinline__ float sigmoidf_(float v) { return __builtin_amdgcn_rcpf(1.0f + __expf(-v)); }
#define LDS_WAIT() asm volatile("s_waitcnt lgkmcnt(0)" ::: "memory")
__device__ __forceinline__ int opaque_tid() { int t = threadIdx.x; asm volatile("" : "+v"(t)); return t; }

namespace pg8 {
constexpr int BM = 256, BK = 64, HALF = 128, HTB = HALF * BK * 2, STAGE_BYTES = 8 * HTB, NXCD = 8, WGM = 8;
__host__ __device__ __forceinline__ int lds_byte(int r, int c) { const int st = (r >> 4) * 2 + (c >> 5), rr = r & 15, cc = c & 31, ob = rr * 64 + cc * 2; return st * 1024 + (ob ^ (((ob >> 9) & 1) << 5)); }
__host__ __device__ __forceinline__ void stage_rc(int b, int& R, int& C) { const int st = b / 1024, sb = b % 1024, swz = sb ^ (((sb >> 9) & 1) << 5); R = (st >> 1) * 16 + swz / 64; C = (st & 1) * 32 + (swz % 64) / 2; }
__host__ __device__ __forceinline__ int perm32(int rho) { const int n = rho >> 4, i = rho & 15; return 8 * (i >> 2) + 4 * n + (i & 3); }

struct Unit { int pm, pn, br; };
struct Gemm { const bf16_t* A; const bf16_t* Bt; int M, N, K; size_t sA, sB; };

struct StaticOrder {
    int nM, nN, nwg, G, c;
    __device__ void init(int M, int N, int G_, int c_) { nM = M / BM; nN = N / BM; nwg = nM * nN; G = G_; c = c_; }
    __device__ __forceinline__ bool next(int i, Unit& u) const {
        const long L = (long)i * G + c; if (L >= nwg) return false;
        int wgid = (int)L; { const int q = nwg / NXCD, r = nwg % NXCD, xcd = wgid % NXCD, off = wgid / NXCD; wgid = (xcd < r ? xcd * (q + 1) : r * (q + 1) + (xcd - r) * q) + off; }
        const int nig = WGM * nN, gid = wgid / nig, fm = gid * WGM, gsz = (nM - fm) < WGM ? (nM - fm) : WGM;
        u.pm = fm + ((wgid % nig) % gsz); u.pn = (wgid % nig) / gsz; u.br = 0; return true;
    }
};
struct Order3 : StaticOrder {
    __device__ __forceinline__ bool next(int i, Unit& u) const { if (!StaticOrder::next(i / 3, u)) return false; u.br = i % 3; return true; }
};

template <class Epi, class Sched>
__device__ __forceinline__ void gemm_phase(LAS unsigned char* lds, const Gemm g, const Sched& S, const Epi& E) {
    const int tid = opaque_tid(), wid = __builtin_amdgcn_readfirstlane(tid >> 6), lane = tid & 63, wr = wid >> 2, wc = wid & 3, fr = lane & 15, fq = lane >> 4;
    const int K = g.K, nt = K / BK;
    unsigned voffA[2], voffB[2];
#pragma unroll
    for (int i = 0; i < 2; ++i) { int R, C; stage_rc(tid * 16 + i * 8192, R, C); const int Rb = (R & ~31) + perm32(R & 31);
        voffA[i] = (unsigned)(R * K + C) * 2u; voffB[i] = (unsigned)(Rb * K + C) * 2u; }
    const size_t kstep = (size_t)(BK * 2);
    const size_t hstep = (size_t)HALF * K * 2;
    const size_t tstep = 2 * hstep;
    const unsigned ldsw = (unsigned)wid * 1024u;
    const int aoff = lds_byte(wr * 64 + fr, fq * 8), boff = lds_byte(wc * 32 + fr, fq * 8);
#define PG8_SA(b, h) (((b) * 2 + (h)) * HTB)
#define PG8_SB(b, h) ((4 + (b) * 2 + (h)) * HTB)
#define PG8_STAGE(bufoff, gbase, voff) do { _Pragma("unroll") for (int _i = 0; _i < 2; ++_i) \
        __builtin_amdgcn_global_load_lds((const unsigned*)((const char*)(gbase) + (voff)[_i]), (LAS unsigned*)(lds + (bufoff) + ldsw + _i * 8192), 16, 0, 0); } while (0)
#define PG8_LDA(dst, b, h) do { _Pragma("unroll") for (int m = 0; m < 4; ++m) _Pragma("unroll") for (int k = 0; k < 2; ++k) dst[m][k] = *(const LAS bf16x8*)(lds + PG8_SA(b, h) + aoff + m * 2048 + k * 1024); } while (0)
#define PG8_LDB(dst, b, h) do { _Pragma("unroll") for (int n = 0; n < 2; ++n) _Pragma("unroll") for (int k = 0; k < 2; ++k) dst[n][k] = *(const LAS bf16x8*)(lds + PG8_SB(b, h) + boff + n * 2048 + k * 1024); } while (0)
#define PG8_MMA(ai, bj, At, Bt) do { __builtin_amdgcn_s_setprio(1); _Pragma("unroll") for (int m = 0; m < 4; ++m) _Pragma("unroll") for (int n = 0; n < 2; ++n) _Pragma("unroll") for (int k = 0; k < 2; ++k) \
        acc[ai][bj][m][n] = __builtin_amdgcn_mfma_f32_16x16x32_bf16(Bt[n][k], At[m][k], acc[ai][bj][m][n], 0, 0, 0); __builtin_amdgcn_s_setprio(0); } while (0)
#define PG8_WAIT_V(n) asm volatile("s_waitcnt vmcnt(" #n ")" ::: "memory")
#define PG8_WAIT_L(n) asm volatile("s_waitcnt lgkmcnt(" #n ")" ::: "memory")
#define PG8_BAR __builtin_amdgcn_s_barrier()
#define PG8_SCHED __builtin_amdgcn_sched_barrier(0)
    Unit cur, nxt; int ui = 0;
    if (!S.next(0, cur)) return;
    f32x4 acc[2][2][4][2];
#pragma unroll
    for (int a = 0; a < 2; ++a)
#pragma unroll
        for (int b = 0; b < 2; ++b)
#pragma unroll
            for (int m = 0; m < 4; ++m)
#pragma unroll
                for (int n = 0; n < 2; ++n) acc[a][b][m][n] = (f32x4){0.f, 0.f, 0.f, 0.f};
    bf16x8 At[4][2], B0[2][2], B1[2][2];
    const char* cA = (const char*)g.A + (size_t)cur.br * g.sA + (size_t)cur.pm * tstep; const char* cB = (const char*)g.Bt + (size_t)cur.br * g.sB + (size_t)cur.pn * tstep;
    PG8_STAGE(PG8_SB(0, 0), cB, voffB); PG8_STAGE(PG8_SB(0, 1), cB + hstep, voffB); PG8_STAGE(PG8_SA(0, 0), cA, voffA); PG8_STAGE(PG8_SA(0, 1), cA + hstep, voffA);
    if (wr == 1) PG8_BAR;
    PG8_WAIT_V(2); PG8_BAR;
    PG8_STAGE(PG8_SB(1, 0), cB + kstep, voffB); PG8_STAGE(PG8_SA(1, 0), cA + kstep, voffA); PG8_STAGE(PG8_SB(1, 1), cB + hstep + kstep, voffB);
    PG8_WAIT_V(6); PG8_BAR;
    for (;;) {
        const bool has_next = S.next(ui + 1, nxt);
        const char* nA = has_next ? (const char*)g.A + (size_t)nxt.br * g.sA + (size_t)nxt.pm * tstep : cA; const char* nB = has_next ? (const char*)g.Bt + (size_t)nxt.br * g.sB + (size_t)nxt.pn * tstep : cB;
        for (int t = 0; t < nt; t += 2) {
            const bool last = (t == nt - 2);
            const char* a1 = cA + (size_t)(t + 1) * kstep;
            const char* a2 = last ? nA : cA + (size_t)(t + 2) * kstep; const char* b2 = last ? nB : cB + (size_t)(t + 2) * kstep;
            const char* a3 = a2 + kstep; const char* b3 = b2 + kstep;
            PG8_LDB(B0, 0, 0); PG8_LDB(B1, 0, 1); PG8_SCHED; PG8_LDA(At, 0, 0); PG8_STAGE(PG8_SA(1, 1), a1 + hstep, voffA);
            PG8_WAIT_V(8); PG8_WAIT_L(0); PG8_BAR; PG8_MMA(0, 0, At, B0); PG8_MMA(0, 1, At, B1); PG8_BAR; PG8_SCHED;
            PG8_LDA(At, 0, 1); PG8_STAGE(PG8_SB(0, 0), b2, voffB); PG8_STAGE(PG8_SB(0, 1), b2 + hstep, voffB); PG8_STAGE(PG8_SA(0, 0), a2, voffA);
            PG8_WAIT_V(8); PG8_WAIT_L(0); PG8_BAR; PG8_MMA(1, 0, At, B0); PG8_MMA(1, 1, At, B1); PG8_BAR; PG8_SCHED;
            PG8_LDB(B0, 1, 0); PG8_LDB(B1, 1, 1); PG8_SCHED; PG8_LDA(At, 1, 0); PG8_STAGE(PG8_SA(0, 1), a2 + hstep, voffA);
            PG8_WAIT_V(8); PG8_WAIT_L(0); PG8_BAR; PG8_MMA(0, 0, At, B0); PG8_MMA(0, 1, At, B1); PG8_BAR; PG8_SCHED;
            PG8_LDA(At, 1, 1); PG8_STAGE(PG8_SB(1, 0), b3, voffB); PG8_STAGE(PG8_SB(1, 1), b3 + hstep, voffB); PG8_STAGE(PG8_SA(1, 0), a3, voffA);
            PG8_WAIT_V(8); PG8_WAIT_L(0); PG8_BAR; PG8_MMA(1, 0, At, B0); PG8_MMA(1, 1, At, B1); PG8_BAR; PG8_SCHED;
        }
        if (wr == 0) PG8_BAR;
        const bool reset = E(acc, cur, wr, wc, fr, fq);
        if (!has_next) break;
        if (reset) {
#pragma unroll
            for (int a = 0; a < 2; ++a)
#pragma unroll
                for (int b = 0; b < 2; ++b)
#pragma unroll
                    for (int m = 0; m < 4; ++m)
#pragma unroll
                        for (int n = 0; n < 2; ++n) acc[a][b][m][n] = (f32x4){0.f, 0.f, 0.f, 0.f};
        }
        cur = nxt; cA = nA; cB = nB; ++ui;
        if (wr == 1) PG8_BAR;
    }
    PG8_WAIT_V(0);
    PG8_BAR;
#undef PG8_SA
#undef PG8_SB
#undef PG8_STAGE
#undef PG8_LDA
#undef PG8_LDB
#undef PG8_MMA
#undef PG8_WAIT_V
#undef PG8_WAIT_L
#undef PG8_BAR
#undef PG8_SCHED
}
}
using pg8::Unit;

struct EpiZ {
    bf16_t* Z; const u64* ssq; const float* lbs;
    __device__ __forceinline__ bool operator()(f32x4 (&acc)[2][2][4][2], const Unit& u, int wr, int wc, int fr, int fq) const {
        const int seg = u.pn < 32 ? (u.pn >> 2) : 8;
        const int mode = (seg == 8) ? 2 : (seg == 5 ? 3 : ((seg == 1 || seg == 3 || seg == 4 || seg == 7) ? 1 : 0));
        const int zadd = seg >= 6 ? 1024 : 0;
        float rs[2][4];
#pragma unroll
        for (int ai = 0; ai < 2; ++ai)
#pragma unroll
            for (int m = 0; m < 4; ++m) rs[ai][m] = ssq_rstd(ssq + u.pm * 256 + ai * 128 + wr * 64 + m * 16 + fr);
        f32x4 lbv[2][2];
#pragma unroll
        for (int bj = 0; bj < 2; ++bj) {
            const int cl = (mode == 3) ? (u.pn * 256 + bj * 128 + wc * 32 + 8 * fq - 5120) : 0;
            lbv[bj][0] = *(const f32x4*)(lbs + cl); lbv[bj][1] = *(const f32x4*)(lbs + cl + 4);
        }
#pragma unroll
        for (int ai = 0; ai < 2; ++ai)
#pragma unroll
            for (int m = 0; m < 4; ++m) {
                const int row = u.pm * 256 + ai * 128 + wr * 64 + m * 16 + fr;
#pragma unroll
                for (int bj = 0; bj < 2; ++bj) {
                    const int c = u.pn * 256 + bj * 128 + wc * 32 + 8 * fq;
                    float v[8];
#pragma unroll
                    for (int j = 0; j < 4; ++j) { v[j] = acc[ai][bj][m][0][j] * rs[ai][m]; v[4 + j] = acc[ai][bj][m][1][j] * rs[ai][m]; }
                    bf16_t* zp = Z + (size_t)row * ZW + c + zadd;
                    if (mode == 3) {
                        float gl[8], kk[8];
#pragma unroll
                        for (int j = 0; j < 8; ++j) {
                            const float lb = j < 4 ? lbv[bj][0][j] : lbv[bj][1][j - 4];
                            const float e = __expf(-v[j]); const float sg = __builtin_amdgcn_rcpf(1.0f + e);
                            const float f = lb + (1.0f - lb) * sg;
                            gl[j] = __logf(f); kk[j] = (1.0f - lb) * (e * sg);
                        }
                        u32x4 w0, w1;
                        w0.x = pk2(gl[0], gl[1]); w0.y = pk2(gl[2], gl[3]); w0.z = pk2(gl[4], gl[5]); w0.w = pk2(gl[6], gl[7]);
                        w1.x = pk2(kk[0], kk[1]); w1.y = pk2(kk[2], kk[3]); w1.z = pk2(kk[4], kk[5]); w1.w = pk2(kk[6], kk[7]);
                        *(u32x4*)zp = w0; *(u32x4*)(zp + 1024) = w1;
                    } else {
                        float o[8];
                        if (mode == 0) {
#pragma unroll
                            for (int j = 0; j < 8; ++j) o[j] = v[j];
                        } else if (mode == 1) {
#pragma unroll
                            for (int j = 0; j < 8; ++j) o[j] = v[j] * __builtin_amdgcn_rcpf(1.0f + __expf(-v[j]));
                        } else {
#pragma unroll
                            for (int j = 0; j < 8; ++j) o[j] = __builtin_amdgcn_rcpf(1.0f + __expf(-v[j]));
                        }
                        u32x4 w0; w0.x = pk2t(o[0], o[1]); w0.y = pk2t(o[2], o[3]); w0.z = pk2t(o[4], o[5]); w0.w = pk2t(o[6], o[7]);
                        *(u32x4*)zp = w0;
                    }
                }
            }
        return true;
    }
};
struct EpiGlu {
    const bf16_t* Ypre; const bf16_t* Z; const float* bglu; bf16_t* Ya;
    __device__ __forceinline__ bool operator()(f32x4 (&acc)[2][2][4][2], const Unit& u, int wr, int wc, int fr, int fq) const {
        f32x4 bv[2][2];
#pragma unroll
        for (int bj = 0; bj < 2; ++bj) { const int c = u.pn * 256 + bj * 128 + wc * 32 + 8 * fq; bv[bj][0] = *(const f32x4*)(bglu + c); bv[bj][1] = *(const f32x4*)(bglu + c + 4); }
#pragma unroll
        for (int ai = 0; ai < 2; ++ai) {
            u32x4 yp[4][2], sg[4][2];
#pragma unroll
            for (int m = 0; m < 4; ++m)
#pragma unroll
                for (int bj = 0; bj < 2; ++bj) {
                    const int row = u.pm * 256 + ai * 128 + wr * 64 + m * 16 + fr, c = u.pn * 256 + bj * 128 + wc * 32 + 8 * fq;
                    yp[m][bj] = *(const u32x4*)(Ypre + (size_t)row * WM + c); sg[m][bj] = *(const u32x4*)(Z + (size_t)row * ZW + 1024 + c);
                }
            __builtin_amdgcn_sched_barrier(0);
#pragma unroll
            for (int m = 0; m < 4; ++m)
#pragma unroll
                for (int bj = 0; bj < 2; ++bj) {
                    const int row = u.pm * 256 + ai * 128 + wr * 64 + m * 16 + fr, c = u.pn * 256 + bj * 128 + wc * 32 + 8 * fq;
                    float o[8];
#pragma unroll
                    for (int j = 0; j < 8; ++j) {
                        const float a = (j < 4 ? acc[ai][bj][m][0][j] : acc[ai][bj][m][1][j - 4]) + (j < 4 ? bv[bj][0][j] : bv[bj][1][j - 4]);
                        const unsigned ypw = yp[m][bj][j >> 1], sgw = sg[m][bj][j >> 1];
                        const float y = (j & 1) ? bfhi(ypw) : bflo(ypw), s = (j & 1) ? bfhi(sgw) : bflo(sgw);
                        o[j] = y * sigmoidf_(a) * s;
                    }
                    u32x4 w0; w0.x = pk2(o[0], o[1]); w0.y = pk2(o[2], o[3]); w0.z = pk2(o[4], o[5]); w0.w = pk2(o[6], o[7]);
                    *(u32x4*)(Ya + (size_t)row * WM + c) = w0;
                }
            __builtin_amdgcn_sched_barrier(0);
        }
        return true;
    }
};
struct EpiBr {
    const bf16_t* Z; bf16_t* Mrg;
    __device__ __forceinline__ bool operator()(f32x4 (&acc)[2][2][4][2], const Unit& u, int wr, int wc, int fr, int fq) const {
        const int br = u.br, nb = br < 2 ? br + 1 : br;
#pragma unroll
        for (int ai = 0; ai < 2; ++ai) {
            u32x4 ga[4][2], gb[4][2];
#pragma unroll
            for (int m = 0; m < 4; ++m)
#pragma unroll
                for (int bj = 0; bj < 2; ++bj) {
                    const int row = u.pm * 256 + ai * 128 + wr * 64 + m * 16 + fr, c = u.pn * 256 + bj * 128 + wc * 32 + 8 * fq;
                    const bf16_t* gp = Z + (size_t)row * ZW + 9216 + c;
                    ga[m][bj] = *(const u32x4*)(gp + br * 2048); gb[m][bj] = *(const u32x4*)(gp + nb * 2048);
                }
            __builtin_amdgcn_sched_barrier(0);
#pragma unroll
            for (int m = 0; m < 4; ++m)
#pragma unroll
                for (int bj = 0; bj < 2; ++bj) {
                    const int row = u.pm * 256 + ai * 128 + wr * 64 + m * 16 + fr, c = u.pn * 256 + bj * 128 + wc * 32 + 8 * fq;
                    if (br < 2) {
#pragma unroll
                        for (int j = 0; j < 8; ++j) {
                            const unsigned aw = ga[m][bj][j >> 1], bw = gb[m][bj][j >> 1];
                            const float x = (j & 1) ? bfhi(aw) : bflo(aw), y = (j & 1) ? bfhi(bw) : bflo(bw);
                            const float r = x * __builtin_amdgcn_rcpf(fmaxf(y, 1e-30f));
                            if (j < 4) acc[ai][bj][m][0][j] *= r; else acc[ai][bj][m][1][j - 4] *= r;
                        }
                    } else {
                        float o[8];
#pragma unroll
                        for (int j = 0; j < 8; ++j) {
                            const unsigned aw = ga[m][bj][j >> 1];
                            const float x = (j & 1) ? bfhi(aw) : bflo(aw);
                            o[j] = (j < 4 ? acc[ai][bj][m][0][j] : acc[ai][bj][m][1][j - 4]) * x;
                        }
                        u32x4 w0; w0.x = pk2(o[0], o[1]); w0.y = pk2(o[2], o[3]); w0.z = pk2(o[4], o[5]); w0.w = pk2(o[6], o[7]);
                        *(u32x4*)(Mrg + (size_t)row * DM + c) = w0;
                    }
                }
            __builtin_amdgcn_sched_barrier(0);
        }
        return br == 2;
    }
};
struct EpiOut {
    const float* Xin; bf16_t* Xb; u64* ssq;
    __device__ __forceinline__ bool operator()(f32x4 (&acc)[2][2][4][2], const Unit& u, int wr, int wc, int fr, int fq) const {
        const bool first = Xin != nullptr;
#pragma unroll
        for (int ai = 0; ai < 2; ++ai) {
            if (first) {
                f32x4 xi[4][2][2];
#pragma unroll
                for (int m = 0; m < 4; ++m)
#pragma unroll
                    for (int bj = 0; bj < 2; ++bj) {
                        const int row = u.pm * 256 + ai * 128 + wr * 64 + m * 16 + fr, c = u.pn * 256 + bj * 128 + wc * 32 + 8 * fq;
                        xi[m][bj][0] = *(const f32x4*)(Xin + (size_t)row * DM + c); xi[m][bj][1] = *(const f32x4*)(Xin + (size_t)row * DM + c + 4);
                    }
                __builtin_amdgcn_sched_barrier(0);
#pragma unroll
                for (int m = 0; m < 4; ++m)
#pragma unroll
                    for (int bj = 0; bj < 2; ++bj) { acc[ai][bj][m][0] += xi[m][bj][0]; acc[ai][bj][m][1] += xi[m][bj][1]; }
            } else {
                u32x4 xw[4][2];
#pragma unroll
                for (int m = 0; m < 4; ++m)
#pragma unroll
                    for (int bj = 0; bj < 2; ++bj) {
                        const int row = u.pm * 256 + ai * 128 + wr * 64 + m * 16 + fr, c = u.pn * 256 + bj * 128 + wc * 32 + 8 * fq;
                        xw[m][bj] = *(const u32x4*)(Xb + (size_t)row * DM + c);
                    }
                __builtin_amdgcn_sched_barrier(0);
#pragma unroll
                for (int m = 0; m < 4; ++m)
#pragma unroll
                    for (int bj = 0; bj < 2; ++bj) {
                        const u32x4 w = xw[m][bj];
                        acc[ai][bj][m][0] += (f32x4){bflo(w.x), bfhi(w.x), bflo(w.y), bfhi(w.y)}; acc[ai][bj][m][1] += (f32x4){bflo(w.z), bfhi(w.z), bflo(w.w), bfhi(w.w)};
                    }
            }
#pragma unroll
            for (int m = 0; m < 4; ++m) {
                const int row = u.pm * 256 + ai * 128 + wr * 64 + m * 16 + fr;
                float part = 0.f;
#pragma unroll
                for (int bj = 0; bj < 2; ++bj) {
                    const int c = u.pn * 256 + bj * 128 + wc * 32 + 8 * fq;
                    const f32x4 v0 = acc[ai][bj][m][0], v1 = acc[ai][bj][m][1];
                    u32x4 w0; w0.x = pk2(v0[0], v0[1]); w0.y = pk2(v0[2], v0[3]); w0.z = pk2(v1[0], v1[1]); w0.w = pk2(v1[2], v1[3]);
                    *(u32x4*)(Xb + (size_t)row * DM + c) = w0;
                    part += v0[0] * v0[0] + v0[1] * v0[1] + v0[2] * v0[2] + v0[3] * v0[3] + v1[0] * v1[0] + v1[1] * v1[1] + v1[2] * v1[2] + v1[3] * v1[3];
                }
                part += __shfl_xor(part, 16); part += __shfl_xor(part, 32);
                if (fq == 0) atomicAdd(ssq + row, (u64)(part * 16777216.0f));
            }
            __builtin_amdgcn_sched_barrier(0);
        }
        return true;
    }
};

__device__ __forceinline__ void mma32(f32x16& acc, const LAS bf16_t* A, int lda, const LAS bf16_t* Bt, int ldb, int K, int lane) {
    const int r = lane & 31, h = lane >> 5;
    const LAS bf16_t* pa = A + r * lda + 8 * h; const LAS bf16_t* pb = Bt + r * ldb + 8 * h;
    for (int k = 0; k < K; k += 16) {
        const bf16x8 a = *(const LAS bf16x8*)(pa + k); const bf16x8 b = *(const LAS bf16x8*)(pb + k);
        acc = __builtin_amdgcn_mfma_f32_32x32x16_bf16(a, b, acc, 0, 0, 0);
    }
}
__device__ __forceinline__ int row32(int reg, int lane) { return (reg & 3) + 8 * (reg >> 2) + 4 * (lane >> 5); }

__device__ __forceinline__ void transpose_item(const float* W, int K, int N, bf16_t* WT, const float* scale, LAS float* scr, int item, int lane) {
    const int nkb = K / 64, kb = item % nkb, nb = item / nkb, k0 = 64 * kb, n0 = 64 * nb;
    const int r = lane >> 4, c4 = lane & 15;
    f32x4 vv[16];
#pragma unroll
    for (int i = 0; i < 16; ++i) vv[i] = *(const f32x4*)(W + (size_t)(k0 + 4 * i + r) * N + n0 + 4 * c4);
    if (scale) {
#pragma unroll
        for (int i = 0; i < 16; ++i) vv[i] = vv[i] * scale[k0 + 4 * i + r];
    }
#pragma unroll
    for (int i = 0; i < 16; ++i) {
        LAS float* d = scr + (4 * i + r) * 65 + 4 * c4;
        d[0] = vv[i][0]; d[1] = vv[i][1]; d[2] = vv[i][2]; d[3] = vv[i][3];
    }
    LDS_WAIT();
    const int cch = lane & 7;
#pragma unroll
    for (int j = 0; j < 8; ++j) { const int n = (lane >> 3) + 8 * j; const LAS float* s = scr + (8 * cch) * 65 + n;
        u32x4 o; o.x = pk2(s[0], s[65]); o.y = pk2(s[2 * 65], s[3 * 65]); o.z = pk2(s[4 * 65], s[5 * 65]); o.w = pk2(s[6 * 65], s[7 * 65]);
        *(u32x4*)(WT + (size_t)(n0 + n) * K + k0 + 8 * cch) = o; }
    LDS_WAIT();
}

struct Args { const float* in[25]; float* out; unsigned char* ws; };

__device__ __forceinline__ void phase_prep(const Args& a, LAS unsigned char* lds) {
    const int tid = opaque_tid(), lane = tid & 63, wave = tid >> 6;
    unsigned char* ws = a.ws;
    {
        LAS float* scr = (LAS float*)(lds + wave * 16640);
        const int gw = blockIdx.x * 8 + wave, NGW = gridDim.x * 8;
        constexpr int I_IN = 32 * 224, I_GLU = 16 * 16, I_BR = 16 * 32, I_OUT = 32 * 32, I_L = I_IN + I_GLU + 3 * I_BR + I_OUT;
        for (int it = gw; it < DEPTH * I_L; it += NGW) {
            const int l = it / I_L; int r = it % I_L;
            if (r < I_IN) { transpose_item(a.in[2] + (size_t)l * DM * NIN, DM, NIN, (bf16_t*)(ws + OFF_WIN) + (size_t)l * NIN * DM, a.in[1] + l * DM, scr, r, lane); continue; } r -= I_IN;
            if (r < I_GLU) { transpose_item(a.in[11] + (size_t)l * WM * WM, WM, WM, (bf16_t*)(ws + OFF_WGLU) + (size_t)l * WM * WM, nullptr, scr, r, lane); continue; } r -= I_GLU;
            if (r < 3 * I_BR) { const int br = r / I_BR; r %= I_BR;
                transpose_item(a.in[22] + ((size_t)l * 3 + br) * WM * DM, WM, DM, (bf16_t*)(ws + OFF_WBR) + ((size_t)l * 3 + br) * DM * WM, nullptr, scr, r, lane); continue; } r -= 3 * I_BR;
            transpose_item(a.in[23] + (size_t)l * DM * DM, DM, DM, (bf16_t*)(ws + OFF_WOUT) + (size_t)l * DM * DM, nullptr, scr, r, lane);
        }
    }
    {
        const float* x = a.in[0]; bf16_t* xb = (bf16_t*)(ws + OFF_XB); u64* ssq = (u64*)(ws + OFF_SSQ);
        for (int row = blockIdx.x * 8 + wave; row < T_TOK; row += gridDim.x * 8) {
            float s = 0.f;
#pragma unroll
            for (int j = 0; j < 8; ++j) {
                const f32x4 v = *(const f32x4*)(x + (size_t)row * DM + 4 * lane + 256 * j);
                s += v[0] * v[0] + v[1] * v[1] + v[2] * v[2] + v[3] * v[3];
                u32x2 w; w.x = pk2(v[0], v[1]); w.y = pk2(v[2], v[3]);
                *(u32x2*)(xb + (size_t)row * DM + 4 * lane + 256 * j) = w;
            }
#pragma unroll
            for (int o = 1; o < 64; o <<= 1) s += __shfl_xor(s, o);
            if (lane == 0) ssq[row] = (u64)(s * 16777216.0f);
        }
    }
    const int gt = blockIdx.x * 512 + tid, NT = gridDim.x * 512;
    { u64* ssq = (u64*)(ws + OFF_SSQ) + T_TOK; for (int i = gt; i < 4 * T_TOK; i += NT) ssq[i] = 0ull; }
    for (int i = gt; i < WM; i += NT) {
        const float* hb = a.in[20]; const float v0 = hb[i], v1 = hb[WM + i], v2 = hb[2 * WM + i], v3 = hb[3 * WM + i];
        const float mx = fmaxf(fmaxf(v0, v1), fmaxf(v2, v3));
        const float e0 = expf(v0 - mx), e1 = expf(v1 - mx), e2 = expf(v2 - mx), e3 = expf(v3 - mx), inv = 1.0f / (e0 + e1 + e2 + e3);
        float* lbs = (float*)(ws + OFF_LBS);
        lbs[i] = 0.f; lbs[WM + i] = e1 * inv; lbs[2 * WM + i] = (e1 + e2) * inv; lbs[3 * WM + i] = (e1 + e2 + e3) * inv;
    }
    for (int i = gt; i < DEPTH * 64 * 64; i += NT) {
        const int l = i >> 12, g = (i >> 6) & 63, p = i & 63;
        const float lre = a.in[3][i], lim = a.in[4][i], step = expf(a.in[5][l * 64 + g]);
        const float mag = expf(lre * step), ang = lim * step;
        const float are = mag * cosf(ang), aim = mag * sinf(ang);
        const float nre = are - 1.0f, nim = aim, den = lre * lre + lim * lim;
        const float cre = (nre * lre + nim * lim) / den, cim = (nim * lre - nre * lim) / den;
        ((float2*)(ws + OFF_S5A))[i] = make_float2(are, aim);
        const float* bre = a.in[6] + (size_t)i * 16; const float* bim = a.in[7] + (size_t)i * 16;
        bf16_t* bt = (bf16_t*)(ws + OFF_S5BT) + ((size_t)(l * 64 + g) * 128) * 16;
        bf16_t* ct = (bf16_t*)(ws + OFF_S5CT) + ((size_t)(l * 64 + g) * 16) * 128;
        const float* cr = a.in[8] + (size_t)(l * 64 + g) * 16 * 64; const float* ci = a.in[9] + (size_t)(l * 64 + g) * 16 * 64;
#pragma unroll 4
        for (int h = 0; h < 16; ++h) {
            const float br_ = bre[h], bi_ = bim[h];
            bt[(size_t)(2 * p) * 16 + h] = f2bf(cre * br_ - cim * bi_);
            bt[(size_t)(2 * p + 1) * 16 + h] = f2bf(cre * bi_ + cim * br_);
            ct[(size_t)h * 128 + 2 * p] = f2bf(cr[h * 64 + p]);
            ct[(size_t)h * 128 + 2 * p + 1] = f2bf(-ci[h * 64 + p]);
        }
    }
    for (int i = gt; i < DEPTH * 16 * 128 * 64; i += NT) {
        const int ii = i & 63, j = (i >> 6) & 127, ln = i >> 13;
        const float v = j < 64 ? a.in[15][(size_t)ln * 4096 + ii * 64 + j] : a.in[17][(size_t)ln * 4096 + ii * 64 + (j - 64)];
        ((bf16_t*)(ws + OFF_RGW))[i] = f2bf(v);
    }
}

__device__ __forceinline__ void s5_item(LAS unsigned char* lds, const bf16_t* Z, bf16_t* Ypre, const float2* abar, const bf16_t* BT, const bf16_t* CT, const float* dvec, int b, int g) {
    const int tid = opaque_tid(), lane = tid & 63, w = __builtin_amdgcn_readfirstlane(tid >> 6);
    const int r = lane & 31, h = lane >> 5;
    const size_t Rb = (size_t)b * SEQ;
    if (w >= 4) {
        const int nt = w - 4;
        const bf16x8 bfrag = *(const bf16x8*)(BT + (size_t)(32 * nt + r) * 16 + 8 * h);
        const bf16_t* zA = Z + (Rb + r) * ZW + g * 16 + 8 * h;
        bf16x8 a0n = *(const bf16x8*)zA, a1n = *(const bf16x8*)(zA + (size_t)32 * ZW);
#pragma unroll 1
        for (int it = 0; it < 66; ++it) {
            if (it < 64) {
                const bf16x8 a0 = a0n, a1 = a1n;
                if (it + 1 < 64) { a0n = *(const bf16x8*)(zA + (size_t)(64 * (it + 1)) * ZW); a1n = *(const bf16x8*)(zA + (size_t)(64 * (it + 1) + 32) * ZW); }
                LAS float* BU = (LAS float*)(lds + (it & 1) * 32768);
                f32x16 acc;
#pragma unroll
                for (int i = 0; i < 16; ++i) acc[i] = 0.f;
                acc = __builtin_amdgcn_mfma_f32_32x32x16_bf16(a0, bfrag, acc, 0, 0, 0);
#pragma unroll
                for (int reg = 0; reg < 16; ++reg) BU[row32(reg, lane) * 128 + 32 * nt + r] = acc[reg];
#pragma unroll
                for (int i = 0; i < 16; ++i) acc[i] = 0.f;
                acc = __builtin_amdgcn_mfma_f32_32x32x16_bf16(a1, bfrag, acc, 0, 0, 0);
#pragma unroll
                for (int reg = 0; reg < 16; ++reg) BU[(32 + row32(reg, lane)) * 128 + 32 * nt + r] = acc[reg];
            }
            __syncthreads();
        }
    } else if (w == 0) {
        const float2 ab = abar[lane];
        float xr = 0.f, xi = 0.f;
        __builtin_amdgcn_s_setprio(3);
#pragma unroll 1
        for (int it = 0; it < 66; ++it) {
            if (it >= 1 && it <= 64) {
                const LAS float* BU = (const LAS float*)(lds + ((it - 1) & 1) * 32768);
                LAS bf16_t* XS = (LAS bf16_t*)(lds + 65536 + ((it - 1) & 1) * 17408);
                f32x2 bb[2][16];
#pragma unroll
                for (int i = 0; i < 16; ++i) bb[0][i] = *(const LAS f32x2*)(BU + i * 128 + 2 * lane);
#pragma unroll
                for (int tb = 0; tb < 4; ++tb) {
                    if (tb < 3) {
#pragma unroll
                        for (int i = 0; i < 16; ++i) bb[(tb + 1) & 1][i] = *(const LAS f32x2*)(BU + (16 * (tb + 1) + i) * 128 + 2 * lane);
                    }
#pragma unroll
                    for (int i = 0; i < 16; ++i) {
                        const f32x2 bv = bb[tb & 1][i];
                        float t1 = __builtin_fmaf(-ab.y, xi, bv.x), t2 = __builtin_fmaf(ab.y, xr, bv.y);
                        asm("" : "+v"(t1)); asm("" : "+v"(t2));
                        const float nr = __builtin_fmaf(ab.x, xr, t1), ni = __builtin_fmaf(ab.x, xi, t2);
                        xr = nr; xi = ni;
                        *(LAS unsigned*)(XS + (16 * tb + i) * 136 + 2 * lane) = pk2(xr, xi);
                    }
                }
            }
            __syncthreads();
        }
        __builtin_amdgcn_s_setprio(0);
    } else {
        const int nty = w == 1 ? 2 : 1, ty0 = w == 1 ? 0 : w;
        bf16x8 cfrag[4];
#pragma unroll
        for (int ks = 0; ks < 4; ++ks) cfrag[ks] = *(const bf16x8*)(CT + (size_t)(lane & 15) * 128 + 32 * ks + 8 * (lane >> 4));
        const float dd = dvec[g * 16 + (lane & 15)];
        const bf16_t* zU = Z + (Rb + (lane >> 4) * 4) * ZW + g * 16 + (lane & 15);
        bf16_t un[2][4];
#pragma unroll
        for (int q = 0; q < 2; ++q)
#pragma unroll
            for (int reg = 0; reg < 4; ++reg) un[q][reg] = (q < nty) ? zU[(size_t)(16 * (ty0 + q) + reg) * ZW] : (bf16_t)0;
#pragma unroll 1
        for (int it = 0; it < 66; ++it) {
            if (it >= 2) {
                const int c = it - 2;
                const LAS bf16_t* XS = (const LAS bf16_t*)(lds + 65536 + (c & 1) * 17408);
                bf16_t uc[2][4];
#pragma unroll
                for (int q = 0; q < 2; ++q)
#pragma unroll
                    for (int reg = 0; reg < 4; ++reg) uc[q][reg] = un[q][reg];
                if (c + 1 < 64) {
#pragma unroll
                    for (int q = 0; q < 2; ++q)
#pragma unroll
                        for (int reg = 0; reg < 4; ++reg) if (q < nty) un[q][reg] = zU[(size_t)(64 * (c + 1) + 16 * (ty0 + q) + reg) * ZW];
                }
#pragma unroll
                for (int q = 0; q < 2; ++q) {
                    if (q < nty) {
                        const int ty = ty0 + q;
                        f32x4 a4 = (f32x4){0.f, 0.f, 0.f, 0.f};
#pragma unroll
                        for (int ks = 0; ks < 4; ++ks) {
                            const bf16x8 av = *(const LAS bf16x8*)(XS + (16 * ty + (lane & 15)) * 136 + 32 * ks + 8 * (lane >> 4));
                            a4 = __builtin_amdgcn_mfma_f32_16x16x32_bf16(av, cfrag[ks], a4, 0, 0, 0);
                        }
#pragma unroll
                        for (int reg = 0; reg < 4; ++reg) {
                            const int t = 16 * ty + (lane >> 4) * 4 + reg, hh = lane & 15;
                            const float y = a4[reg] + dd * bf2f(uc[q][reg]);
                            const float uu = 0.7978845608f * (y + 0.044715f * y * y * y);
                            const float th = 1.0f - 2.0f * __builtin_amdgcn_rcpf(1.0f + __expf(2.0f * uu));
                            Ypre[(Rb + 64 * c + t) * WM + g * 16 + hh] = f2bf(0.5f * y * (1.0f + th));
                        }
                    }
                }
            }
            __syncthreads();
        }
    }
    __syncthreads();
}

__device__ __forceinline__ unsigned flag_ld(const unsigned* p) { return __hip_atomic_load(p, __ATOMIC_RELAXED, __HIP_MEMORY_SCOPE_AGENT); }
struct RgSetup { float cw0, cw1, cw2, cw3, cb, bias, sp8; bf16x8 wfrag[4]; };
__device__ __forceinline__ RgSetup rg_setup(const bf16_t* WgT, const float* convw, const float* convb, const float* b_a, const float* b_x, const float* lam, int n) {
    const int tid = opaque_tid(), lane = tid & 63, w = __builtin_amdgcn_readfirstlane(tid >> 6);
    RgSetup s; const int ch = n * 64 + lane;
    s.cw0 = convw[ch]; s.cw1 = convw[WM + ch]; s.cw2 = convw[2 * WM + ch]; s.cw3 = convw[3 * WM + ch]; s.cb = convb[ch];
    const int nt = w & 3, r = lane & 31, h = lane >> 5;
#pragma unroll
    for (int ks = 0; ks < 4; ++ks) s.wfrag[ks] = *(const bf16x8*)(WgT + (size_t)(32 * nt + r) * 64 + 16 * ks + 8 * h);
    const int chg = n * 64 + ((32 * nt + r) & 63);
    s.bias = nt < 2 ? b_a[chg] : b_x[chg];
    s.sp8 = 8.0f * log1pf(expf(-lam[chg]));
    return s;
}
__device__ __forceinline__ void rg_item(LAS unsigned char* lds, const bf16_t* Z, bf16_t* Yb, const RgSetup st, int seg, int b, int n, float* summ, unsigned* flags, unsigned want) {
    const int tid = opaque_tid(), lane = tid & 63, w = __builtin_amdgcn_readfirstlane(tid >> 6);
    LAS float* XCf = (LAS float*)lds;
    LAS bf16_t* XCb = (LAS bf16_t*)(lds + 16384);
    LAS float* A_ = (LAS float*)(lds + 25600);
    LAS float* M_ = (LAS float*)(lds + 41984);
    LAS float* IX_ = (LAS float*)(lds + 58368);
    LAS bf16_t* HL = (LAS bf16_t*)(lds + 74752);
    LAS bf16_t* AC = (LAS bf16_t*)(lds + 107520);
    LAS float* HIN = (LAS float*)(lds + 140288);
    LAS float* CA = (LAS float*)(lds + 140544);
    LAS float* CH = (LAS float*)(lds + 142592);
    const int c = lane, oct = w, ch = n * 64 + c;
    const float cw0 = st.cw0, cw1 = st.cw1, cw2 = st.cw2, cw3 = st.cw3, cb = st.cb;
    const int mt = w >> 2, nt = w & 3, r = lane & 31, h = lane >> 5;
    const int cc = (32 * nt + r) & 63;
    const float bias = st.bias, sp8 = st.sp8;
    float hstate = 0.f, aprod = 1.f;
    const int ts = 256 * seg;
    const bf16_t* zx = Z + ((size_t)b * SEQ + ts + 8 * oct) * ZW + 2048 + ch;
    bf16_t xn[11];
#pragma unroll
    for (int i = 0; i < 11; ++i) xn[i] = (ts + 8 * oct - 3 + i >= 0) ? zx[(ptrdiff_t)(i - 3) * ZW] : (bf16_t)0;
    bf16_t sg[32];
    {
        const bf16_t* zs = Z + ((size_t)b * SEQ + ts + 32 * w) * ZW + 3072 + ch;
#pragma unroll
        for (int i = 0; i < 32; ++i) sg[i] = zs[(size_t)i * ZW];
    }
#pragma unroll 1
    for (int tile = 0; tile < 4; ++tile) {
        const int t0 = ts + 64 * tile;
        {
            float xv[11];
#pragma unroll
            for (int i = 0; i < 11; ++i) xv[i] = bf2f(xn[i]);
            if (tile < 3) {
                const bf16_t* zn = zx + (size_t)(64 * (tile + 1)) * ZW;
#pragma unroll
                for (int i = 0; i < 11; ++i) xn[i] = zn[(ptrdiff_t)(i - 3) * ZW];
            }
#pragma unroll
            for (int i = 0; i < 8; ++i) {
                const float xc = cb + cw0 * xv[i] + cw1 * xv[i + 1] + cw2 * xv[i + 2] + cw3 * xv[i + 3];
                const int t = 8 * oct + i;
                XCf[t * 64 + c] = xc; XCb[t * 72 + c] = f2bf(xc);
            }
        }
        __syncthreads();
        {
            f32x16 acc;
#pragma unroll
            for (int i = 0; i < 16; ++i) acc[i] = 0.f;
#pragma unroll
            for (int ks = 0; ks < 4; ++ks) {
                const bf16x8 av = *(const LAS bf16x8*)(XCb + (32 * mt + r) * 72 + 16 * ks + 8 * h);
                acc = __builtin_amdgcn_mfma_f32_32x32x16_bf16(av, st.wfrag[ks], acc, 0, 0, 0);
            }
#pragma unroll
            for (int reg = 0; reg < 16; ++reg) {
                const int t = 32 * mt + row32(reg, lane);
                const float s = sigmoidf_(acc[reg] + bias);
                if (nt < 2) {
                    const float la = -s * sp8; const float av = __expf(la); const float x2 = 2.0f * la;
                    const float m2 = x2 > -0.05f ? -x2 * (1.0f + x2 * (0.5f + x2 * (0.16666667f + x2 * 0.041666667f))) : 1.0f - __expf(x2);
                    float mult = sqrtf(m2); if (t0 + t == 0) mult = 1.0f;
                    A_[t * 64 + cc] = av; M_[t * 64 + cc] = mult;
                } else IX_[t * 64 + cc] = s * XCf[t * 64 + cc];
            }
        }
        __syncthreads();
        {
            float al[8], hl[8];
            {
                float hh = 0.f, pp = 1.f;
#pragma unroll
                for (int i = 0; i < 8; ++i) {
                    const int t = 8 * w + i; const float av = A_[t * 64 + c];
                    hh = av * hh + M_[t * 64 + c] * IX_[t * 64 + c]; pp *= av; hl[i] = hh; al[i] = pp;
                }
                CA[w * 64 + c] = pp; CH[w * 64 + c] = hh;
            }
            __syncthreads();
            float hin = hstate, pin = aprod;
#pragma unroll
            for (int q = 0; q < 8; ++q) {
                const float aq = CA[q * 64 + c], hq = CH[q * 64 + c];
                if (q < w) { hin = aq * hin + hq; pin *= aq; }
                hstate = aq * hstate + hq; aprod *= aq;
            }
#pragma unroll
            for (int i = 0; i < 8; ++i) {
                const int t = 64 * tile + 8 * w + i;
                HL[t * 64 + c] = f2bf(hl[i] + al[i] * hin); AC[t * 64 + c] = f2bf(al[i] * pin);
            }
        }
        __syncthreads();
    }
    const int bn = b * 16 + n;
    if (w == 0) {
        float* sm = summ + ((size_t)(seg * 32 + bn)) * 128;
        __hip_atomic_store(sm + c, aprod, __ATOMIC_RELAXED, __HIP_MEMORY_SCOPE_AGENT);
        __hip_atomic_store(sm + 64 + c, hstate, __ATOMIC_RELAXED, __HIP_MEMORY_SCOPE_AGENT);
        asm volatile("s_waitcnt vmcnt(0)" ::: "memory");
        if (lane == 0) __hip_atomic_store(flags + seg * 32 + bn, want, __ATOMIC_RELAXED, __HIP_MEMORY_SCOPE_AGENT);
        float hin = 0.f;
        if (seg > 0) {
            unsigned spins = 0;
            for (;;) {
                const int ok = (lane < seg) ? (flag_ld(flags + lane * 32 + bn) >= want) : 1;
                if (__all(ok)) break;
                __builtin_amdgcn_s_sleep(2);
                if (++spins > (1u << 22)) break;
            }
#pragma unroll 1
            for (int s0 = 0; s0 < seg; s0 += 8) {
                float at[8], he[8];
#pragma unroll
                for (int q = 0; q < 8; ++q) {
                    const int s2 = (s0 + q < seg) ? s0 + q : seg - 1;
                    float* p = summ + ((size_t)(s2 * 32 + bn)) * 128;
                    at[q] = __hip_atomic_load(p + c, __ATOMIC_RELAXED, __HIP_MEMORY_SCOPE_AGENT); he[q] = __hip_atomic_load(p + 64 + c, __ATOMIC_RELAXED, __HIP_MEMORY_SCOPE_AGENT);
                }
#pragma unroll
                for (int q = 0; q < 8; ++q) if (s0 + q < seg) hin = at[q] * hin + he[q];
            }
        }
        HIN[c] = hin;
    }
    __syncthreads();
    {
        const float hin = HIN[c];
        bf16_t* yo = Yb + ((size_t)b * SEQ + ts + 32 * w) * WM + ch;
#pragma unroll
        for (int i = 0; i < 32; ++i) {
            const int t = 32 * w + i;
            yo[(size_t)i * WM] = f2bf((bf2f(HL[t * 64 + c]) + bf2f(AC[t * 64 + c]) * hin) * bf2f(sg[i]));
        }
    }
    __syncthreads();
}

__device__ __forceinline__ void hg_item(LAS unsigned char* lds, const bf16_t* Z, bf16_t* Yc, const float* normw, int b, int hd, int seg,
                                        float* OL, bf16_t* QH, float* USEG, float* DSEG, unsigned* flags, unsigned want) {
    const int tid = opaque_tid(), lane = tid & 63, w = __builtin_amdgcn_readfirstlane(tid >> 6);
    LAS float* Of = (LAS float*)lds;
    LAS bf16_t* QT = (LAS bf16_t*)(lds + 32768);
    LAS bf16_t* KT = (LAS bf16_t*)(lds + 50176);
    LAS bf16_t* KTT = (LAS bf16_t*)(lds + 67584);
    LAS bf16_t* VT = (LAS bf16_t*)(lds + 86016);
    LAS bf16_t* PP = (LAS bf16_t*)(lds + 104448);
    LAS bf16_t* ST = (LAS bf16_t*)(lds + 113664);
    LAS float* TOT = (LAS float*)(lds + 148480);
    LAS float* E1 = (LAS float*)(lds + 152576);
    LAS float* E2 = (LAS float*)(lds + 153088);
    const int t_ = tid >> 3, cg_ = (tid & 7) * 16;
    const int kp = lane;
    const int kt = w >> 1, vt0 = 2 * (w & 1);
    const int mt = w >> 2, vt = w & 3;
    const int bh = b * 8 + hd, item = seg * 16 + bh;
    const size_t Rs = (size_t)b * SEQ + 512 * seg;
    f32x16 S0, S1;
#pragma unroll
    for (int i = 0; i < 16; ++i) { S0[i] = 0.f; S1[i] = 0.f; }
    float gacc0 = 0.f, gacc1 = 0.f;
    {
    const bf16_t* zc0 = Z + (Rs + 8 * w) * ZW + hd * 128 + 2 * kp;
    unsigned nq[8], nk[8], ng[8], nv[8];
#pragma unroll
    for (int i = 0; i < 8; ++i) { const bf16_t* p = zc0 + (size_t)i * ZW; nq[i] = *(const unsigned*)(p + 4096); ng[i] = *(const unsigned*)(p + 5120); nk[i] = *(const unsigned*)(p + 6144); nv[i] = *(const unsigned*)(p + 7168); }
#pragma unroll 1
    for (int c = 0; c < 8; ++c) {
        const size_t R0 = Rs + 64 * c;
        unsigned q2[8], k2[8], v2[8]; float G0[8], G1[8];
        {
            float r0 = 0.f, r1 = 0.f;
#pragma unroll
            for (int i = 0; i < 8; ++i) { q2[i] = nq[i]; k2[i] = nk[i]; v2[i] = nv[i]; r0 += bflo(ng[i]); r1 += bfhi(ng[i]); G0[i] = r0; G1[i] = r1; }
            *(LAS f32x2*)(TOT + w * 128 + 2 * kp) = (f32x2){r0, r1};
        }
        if (c + 1 < 8) {
            const bf16_t* zn = zc0 + (size_t)(64 * (c + 1)) * ZW;
#pragma unroll
            for (int i = 0; i < 8; ++i) { const bf16_t* p = zn + (size_t)i * ZW; nq[i] = *(const unsigned*)(p + 4096); ng[i] = *(const unsigned*)(p + 5120); nk[i] = *(const unsigned*)(p + 6144); nv[i] = *(const unsigned*)(p + 7168); }
        }
        __syncthreads();
        {
            float off0 = 0.f, off1 = 0.f, gm0 = 0.f, gm1 = 0.f, gl0 = 0.f, gl1 = 0.f;
#pragma unroll
            for (int s = 0; s < 8; ++s) {
                const f32x2 tv = *(const LAS f32x2*)(TOT + s * 128 + 2 * kp);
                if (s < w) { off0 += tv.x; off1 += tv.y; }
                if (s < 4) { gm0 += tv.x; gm1 += tv.y; }
                gl0 += tv.x; gl1 += tv.y;
            }
            float ka[8], kb[8];
            bf16_t* qh = QH + (R0 + 8 * w) * WM + hd * 128 + 2 * kp;
#pragma unroll
            for (int i = 0; i < 8; ++i) {
                const float g0 = G0[i] + off0, g1 = G1[i] + off1;
                const float d0 = g0 - gm0, d1 = g1 - gm1;
                const float qf0 = bflo(q2[i]), qf1 = bfhi(q2[i]);
                const float qa = qf0 * __expf(fminf(d0, 80.f)), qb = qf1 * __expf(fminf(d1, 80.f));
                ka[i] = bflo(k2[i]) * __expf(fminf(-d0, 80.f)); kb[i] = bfhi(k2[i]) * __expf(fminf(-d1, 80.f));
                *(LAS unsigned*)(QT + (8 * w + i) * 136 + 2 * kp) = pk2(qa, qb);
                *(LAS unsigned*)(KT + (8 * w + i) * 136 + 2 * kp) = pk2(ka[i], kb[i]);
                *(unsigned*)(qh + (size_t)i * WM) = pk2(qf0 * __expf(g0 + gacc0), qf1 * __expf(g1 + gacc1));
            }
            gacc0 += gl0; gacc1 += gl1;
            u32x4 wa, wb;
            wa.x = pk2(ka[0], ka[1]); wa.y = pk2(ka[2], ka[3]); wa.z = pk2(ka[4], ka[5]); wa.w = pk2(ka[6], ka[7]);
            wb.x = pk2(kb[0], kb[1]); wb.y = pk2(kb[2], kb[3]); wb.z = pk2(kb[4], kb[5]); wb.w = pk2(kb[6], kb[7]);
            *(LAS u32x4*)(KTT + (2 * kp) * 72 + 8 * w) = wa; *(LAS u32x4*)(KTT + (2 * kp + 1) * 72 + 8 * w) = wb;
            wa.x = (v2[0] & 0xffffu) | (v2[1] << 16); wa.y = (v2[2] & 0xffffu) | (v2[3] << 16); wa.z = (v2[4] & 0xffffu) | (v2[5] << 16); wa.w = (v2[6] & 0xffffu) | (v2[7] << 16);
            wb.x = (v2[0] >> 16) | (v2[1] & 0xffff0000u); wb.y = (v2[2] >> 16) | (v2[3] & 0xffff0000u); wb.z = (v2[4] >> 16) | (v2[5] & 0xffff0000u); wb.w = (v2[6] >> 16) | (v2[7] & 0xffff0000u);
            *(LAS u32x4*)(VT + (2 * kp) * 72 + 8 * w) = wa; *(LAS u32x4*)(VT + (2 * kp + 1) * 72 + 8 * w) = wb;
            if (w == 0) { *(LAS f32x2*)(E1 + 2 * kp) = (f32x2){__expf(gm0), __expf(gm1)}; *(LAS f32x2*)(E2 + 2 * kp) = (f32x2){__expf(gl0 - gm0), __expf(gl1 - gm1)}; }
        }
        __syncthreads();
        {
            if (w < 3) {
                const int pm_ = w == 0 ? 0 : 1, ps_ = w == 2 ? 1 : 0;
                f32x16 acc;
#pragma unroll
                for (int i = 0; i < 16; ++i) acc[i] = 0.f;
                mma32(acc, QT + 32 * pm_ * 136, 136, KT + 32 * ps_ * 136, 136, 128, lane);
#pragma unroll
                for (int reg = 0; reg < 16; ++reg) { const int t = 32 * pm_ + row32(reg, lane), s = 32 * ps_ + (lane & 31);
                    PP[t * 72 + s] = f2bf(s <= t ? acc[reg] : 0.f); }
            } else if (w == 3) {
#pragma unroll
                for (int reg = 0; reg < 16; ++reg) PP[row32(reg, lane) * 72 + 32 + (lane & 31)] = 0;
            }
#pragma unroll
            for (int i = 0; i < 4; ++i) {
                const int kk0 = 32 * kt + 8 * i + 4 * (lane >> 5);
                const f32x4 e = *(const LAS f32x4*)(E1 + kk0);
#pragma unroll
                for (int j = 0; j < 4; ++j) { S0[4 * i + j] *= e[j]; S1[4 * i + j] *= e[j]; }
                u32x2 a0, a1; a0.x = pk2(S0[4 * i], S0[4 * i + 1]); a0.y = pk2(S0[4 * i + 2], S0[4 * i + 3]); a1.x = pk2(S1[4 * i], S1[4 * i + 1]); a1.y = pk2(S1[4 * i + 2], S1[4 * i + 3]);
                *(LAS u32x2*)(ST + (32 * vt0 + (lane & 31)) * 136 + kk0) = a0;
                *(LAS u32x2*)(ST + (32 * (vt0 + 1) + (lane & 31)) * 136 + kk0) = a1;
            }
        }
        __syncthreads();
        {
            f32x16 acc;
#pragma unroll
            for (int i = 0; i < 16; ++i) acc[i] = 0.f;
            mma32(acc, QT + 32 * mt * 136, 136, ST + 32 * vt * 136, 136, 128, lane);
            mma32(acc, PP + 32 * mt * 72, 72, VT + 32 * vt * 72, 72, 64, lane);
            float* ol = OL + (R0 + 32 * mt) * WM + hd * 128 + 32 * vt + (lane & 31);
#pragma unroll
            for (int reg = 0; reg < 16; ++reg) ol[(size_t)row32(reg, lane) * WM] = acc[reg];
            mma32(S0, KTT + 32 * kt * 72, 72, VT + 32 * vt0 * 72, 72, 64, lane);
            mma32(S1, KTT + 32 * kt * 72, 72, VT + 32 * (vt0 + 1) * 72, 72, 64, lane);
#pragma unroll
            for (int i = 0; i < 4; ++i) {
                const f32x4 e = *(const LAS f32x4*)(E2 + 32 * kt + 8 * i + 4 * (lane >> 5));
#pragma unroll
                for (int j = 0; j < 4; ++j) { S0[4 * i + j] *= e[j]; S1[4 * i + j] *= e[j]; }
            }
        }
    }
    }
    {
        float* us = USEG + (size_t)item * 16384 + (size_t)(32 * kt) * 128 + 32 * vt0 + (lane & 31);
#pragma unroll
        for (int reg = 0; reg < 16; ++reg) { us[row32(reg, lane) * 128] = S0[reg]; us[row32(reg, lane) * 128 + 32] = S1[reg]; }
        if (w == 0) { DSEG[item * 128 + 2 * kp] = __expf(gacc0); DSEG[item * 128 + 2 * kp + 1] = __expf(gacc1); }
        asm volatile("s_waitcnt vmcnt(0)" ::: "memory");
        __syncthreads();
        if (tid == 0) {
            __builtin_amdgcn_fence(__ATOMIC_RELEASE, "agent");
            asm volatile("s_waitcnt vmcnt(0)" ::: "memory");
            __hip_atomic_store(flags + item, want, __ATOMIC_RELAXED, __HIP_MEMORY_SCOPE_AGENT);
        }
        if (w == 0) {
            if (seg > 0) {
                unsigned spins = 0;
                for (;;) {
                    const int ok = (lane < seg) ? (flag_ld(flags + lane * 16 + bh) >= want) : 1;
                    if (__all(ok)) break;
                    __builtin_amdgcn_s_sleep(2);
                    if (++spins > (1u << 22)) break;
                }
            }
            __builtin_amdgcn_fence(__ATOMIC_ACQUIRE, "agent");
            asm volatile("s_waitcnt vmcnt(0)" ::: "memory");
        }
        __syncthreads();
    }
    {
#pragma unroll
        for (int i = 0; i < 16; ++i) { S0[i] = 0.f; S1[i] = 0.f; }
        if (seg > 0) {
            float dn[16], u0n[16], u1n[16];
            {
                const float* us = USEG + (size_t)bh * 16384 + (size_t)(32 * kt) * 128 + 32 * vt0 + (lane & 31);
                const float* ds = DSEG + bh * 128 + 32 * kt;
#pragma unroll
                for (int reg = 0; reg < 16; ++reg) { dn[reg] = ds[row32(reg, lane)]; u0n[reg] = us[row32(reg, lane) * 128]; u1n[reg] = us[row32(reg, lane) * 128 + 32]; }
            }
#pragma unroll 1
            for (int s2 = 0; s2 < seg; ++s2) {
                float dc[16], u0c[16], u1c[16];
#pragma unroll
                for (int reg = 0; reg < 16; ++reg) { dc[reg] = dn[reg]; u0c[reg] = u0n[reg]; u1c[reg] = u1n[reg]; }
                if (s2 + 1 < seg) {
                    const int it2 = (s2 + 1) * 16 + bh;
                    const float* us = USEG + (size_t)it2 * 16384 + (size_t)(32 * kt) * 128 + 32 * vt0 + (lane & 31);
                    const float* ds = DSEG + it2 * 128 + 32 * kt;
#pragma unroll
                    for (int reg = 0; reg < 16; ++reg) { dn[reg] = ds[row32(reg, lane)]; u0n[reg] = us[row32(reg, lane) * 128]; u1n[reg] = us[row32(reg, lane) * 128 + 32]; }
                }
#pragma unroll
                for (int reg = 0; reg < 16; ++reg) { S0[reg] = dc[reg] * S0[reg] + u0c[reg]; S1[reg] = dc[reg] * S1[reg] + u1c[reg]; }
            }
        }
#pragma unroll
        for (int i = 0; i < 4; ++i) {
            const int kk0 = 32 * kt + 8 * i + 4 * (lane >> 5);
            u32x2 a0, a1; a0.x = pk2(S0[4 * i], S0[4 * i + 1]); a0.y = pk2(S0[4 * i + 2], S0[4 * i + 3]); a1.x = pk2(S1[4 * i], S1[4 * i + 1]); a1.y = pk2(S1[4 * i + 2], S1[4 * i + 3]);
            *(LAS u32x2*)(ST + (32 * vt0 + (lane & 31)) * 136 + kk0) = a0;
            *(LAS u32x2*)(ST + (32 * (vt0 + 1) + (lane & 31)) * 136 + kk0) = a1;
        }
    }
    {
        float nw[16];
#pragma unroll
        for (int i = 0; i < 16; ++i) nw[i] = normw[hd * 128 + cg_ + i];
        const bf16_t* qr = QH + (Rs + t_) * WM + hd * 128 + cg_;
        const bf16_t* zr = Z + (Rs + t_) * ZW + 8192 + hd * 128 + cg_;
        u32x4 h0 = *(const u32x4*)qr, h1 = *(const u32x4*)(qr + 8);
        u32x4 s0 = *(const u32x4*)zr, s1 = *(const u32x4*)(zr + 8);
        const float* ol0 = OL + (Rs + 32 * mt) * WM + hd * 128 + 32 * vt + (lane & 31);
        float oln[16];
#pragma unroll
        for (int reg = 0; reg < 16; ++reg) oln[reg] = ol0[(size_t)row32(reg, lane) * WM];
#pragma unroll 1
        for (int c = 0; c < 8; ++c) {
            const size_t R0 = Rs + 64 * c;
            *(LAS u32x4*)(QT + t_ * 136 + cg_) = h0; *(LAS u32x4*)(QT + t_ * 136 + cg_ + 8) = h1;
            const u32x4 sc0 = s0, sc1 = s1;
            float olv[16];
#pragma unroll
            for (int reg = 0; reg < 16; ++reg) olv[reg] = oln[reg];
            if (c + 1 < 8) {
                h0 = *(const u32x4*)(qr + (size_t)(64 * (c + 1)) * WM); h1 = *(const u32x4*)(qr + (size_t)(64 * (c + 1)) * WM + 8);
                s0 = *(const u32x4*)(zr + (size_t)(64 * (c + 1)) * ZW); s1 = *(const u32x4*)(zr + (size_t)(64 * (c + 1)) * ZW + 8);
#pragma unroll
                for (int reg = 0; reg < 16; ++reg) oln[reg] = ol0[(size_t)(64 * (c + 1) + row32(reg, lane)) * WM];
            }
            __syncthreads();
            {
                f32x16 acc;
#pragma unroll
                for (int i = 0; i < 16; ++i) acc[i] = olv[i];
                mma32(acc, QT + 32 * mt * 136, 136, ST + 32 * vt * 136, 136, 128, lane);
#pragma unroll
                for (int reg = 0; reg < 16; ++reg) Of[(32 * mt + row32(reg, lane)) * 128 + 32 * vt + (lane & 31)] = acc[reg];
            }
            __syncthreads();
            {
                float o[16]; float ss = 0.f;
#pragma unroll
                for (int i = 0; i < 4; ++i) { const f32x4 v = *(const LAS f32x4*)(Of + t_ * 128 + cg_ + 4 * i); o[4 * i] = v[0]; o[4 * i + 1] = v[1]; o[4 * i + 2] = v[2]; o[4 * i + 3] = v[3]; }
#pragma unroll
                for (int i = 0; i < 16; ++i) ss += o[i] * o[i];
                ss += __shfl_xor(ss, 1); ss += __shfl_xor(ss, 2); ss += __shfl_xor(ss, 4);
                const float rs = rsqrtf(ss * (1.0f / 128.0f) + EPS);
#pragma unroll
                for (int j = 0; j < 4; ++j) {
                    o[2 * j] *= rs * nw[2 * j] * bflo(sc0[j]); o[2 * j + 1] *= rs * nw[2 * j + 1] * bfhi(sc0[j]);
                    o[8 + 2 * j] *= rs * nw[8 + 2 * j] * bflo(sc1[j]); o[8 + 2 * j + 1] *= rs * nw[8 + 2 * j + 1] * bfhi(sc1[j]);
                }
                u32x4 w0, w1;
                w0.x = pk2(o[0], o[1]); w0.y = pk2(o[2], o[3]); w0.z = pk2(o[4], o[5]); w0.w = pk2(o[6], o[7]);
                w1.x = pk2(o[8], o[9]); w1.y = pk2(o[10], o[11]); w1.z = pk2(o[12], o[13]); w1.w = pk2(o[14], o[15]);
                bf16_t* yp = Yc + (R0 + t_) * WM + hd * 128 + cg_;
                *(u32x4*)yp = w0; *(u32x4*)(yp + 8) = w1;
            }
        }
    }
    __syncthreads();
}

#define XB_TMO      128
#define XB_XCNT(j)  (256  + 64 * (j))
#define XB_XSUB(j)  (1280 + 64 * (j))
#define XB_XGEN(j)  (2304 + 64 * (j))
#define XB_TOP      3328
#define XB_TOPGEN   3392
#define XCD_BAR_WORDS 3456
#define XB_SPIN_CAP (1u << 22)
__device__ __forceinline__ unsigned xb_ld(unsigned* p)              { return __hip_atomic_load(p, __ATOMIC_RELAXED, __HIP_MEMORY_SCOPE_AGENT); }
__device__ __forceinline__ unsigned xb_add(unsigned* p, unsigned v) { return __hip_atomic_fetch_add(p, v, __ATOMIC_RELAXED, __HIP_MEMORY_SCOPE_AGENT); }
__device__ __forceinline__ unsigned xb_xcc_id() { return (unsigned)__builtin_amdgcn_s_getreg((3 << 11) | 20) & 0xFu; }
#define XB_SPIN(cond, bar) do { unsigned _sp = 0; while (cond) { __builtin_amdgcn_s_sleep(1); \
    if ((++_sp & 255u) == 0u) { if (xb_ld(&(bar)[XB_TMO])) break; if (_sp > XB_SPIN_CAP) { atomicAdd(&(bar)[XB_TMO], 1u); break; } } } } while (0)
struct XcdBarrier { unsigned* bar; unsigned x; volatile LAS unsigned* st; };
__device__ __forceinline__ XcdBarrier xcd_barrier_post(unsigned* bar, volatile LAS unsigned* st) {
    XcdBarrier b; b.bar = bar; b.x = xb_xcc_id(); b.st = st;
    if (threadIdx.x == 0) (void)xb_add(&bar[XB_XCNT(b.x)], 1u);
    return b;
}
__device__ __forceinline__ void xcd_barrier_complete(unsigned* bar, unsigned x, unsigned& nloc, unsigned& nx) {
    const unsigned G = gridDim.x * gridDim.y * gridDim.z;
    unsigned sum, cnt, mine, sp = 0u;
    for (;;) {
        sum = 0u; cnt = 0u; mine = 0u;
#pragma unroll
        for (unsigned j = 0; j < 16; ++j) { const unsigned c = xb_ld(&bar[XB_XCNT(j)]); sum += c; cnt += (c > 0u) ? 1u : 0u; mine = (j == x) ? c : mine; }
        if (sum == G) break;
        __builtin_amdgcn_s_sleep(1);
        if ((++sp & 255u) == 0u) { if (xb_ld(&bar[XB_TMO])) break; if (sp > XB_SPIN_CAP) { atomicAdd(&bar[XB_TMO], 1u); break; } }
    }
    nloc = mine > 0u ? mine : 1u; nx = cnt > 0u ? cnt : 1u;
}
__device__ __forceinline__ void xcd_barrier(const XcdBarrier& b) {
    asm volatile("s_waitcnt vmcnt(0)" ::: "memory");
    __syncthreads();
    if (threadIdx.x == 0) {
        unsigned* bar = b.bar;
        __builtin_amdgcn_s_waitcnt(0);
        unsigned nloc = b.st[0], nx = b.st[1];
        if (nloc == 0u) { xcd_barrier_complete(bar, b.x, nloc, nx); b.st[0] = nloc; b.st[1] = nx; }
        const unsigned old = xb_add(&bar[XB_XSUB(b.x)], 1u);
        const unsigned gen = old / nloc;
        if (old + 1u == (gen + 1u) * nloc) {
            __builtin_amdgcn_fence(__ATOMIC_RELEASE, "agent");
            asm volatile("s_waitcnt vmcnt(0)" ::: "memory");
            const unsigned og = xb_add(&bar[XB_TOP], 1u);
            const unsigned tg = og / nx;
            if (og + 1u == (tg + 1u) * nx) xb_add(&bar[XB_TOPGEN], 1u);
            else XB_SPIN(xb_ld(&bar[XB_TOPGEN]) == tg, bar);
            __builtin_amdgcn_fence(__ATOMIC_ACQUIRE, "agent");
            xb_add(&bar[XB_XGEN(b.x)], 1u);
            asm volatile("s_waitcnt vmcnt(0)" ::: "memory");
        } else {
            XB_SPIN(xb_ld(&bar[XB_XGEN(b.x)]) == gen, bar);
            __builtin_amdgcn_fence(__ATOMIC_ACQUIRE, "agent");
            asm volatile("s_waitcnt vmcnt(0)" ::: "memory");
        }
    }
    __syncthreads();
}

extern "C" __global__ void __launch_bounds__(512, 2) mk_fwd(Args a) {
    extern __shared__ __attribute__((aligned(16))) unsigned char shm[];
    LAS unsigned char* lds = (LAS unsigned char*)shm;
    cg::grid_group grid = cg::this_grid();
    unsigned char* ws = a.ws;
    volatile LAS unsigned* xst = (volatile LAS unsigned*)(lds + LDS_BYTES - 16);
    if (threadIdx.x == 0) { xst[0] = 0u; xst[1] = 0u; }
    __syncthreads();
    const XcdBarrier xb = xcd_barrier_post((unsigned*)(ws + OFF_BAR), xst);
    const int G = gridDim.x, bid = blockIdx.x;
    u64* ssq = (u64*)(ws + OFF_SSQ);
    bf16_t* Xb = (bf16_t*)(ws + OFF_XB);
    bf16_t* Z = (bf16_t*)(ws + OFF_Z);
    bf16_t* Ypre = (bf16_t*)(ws + OFF_YPRE);
    bf16_t* Y3 = (bf16_t*)(ws + OFF_Y3);
    bf16_t* Mrg = (bf16_t*)(ws + OFF_MRG);

    phase_prep(a, lds);
    grid.sync();

#pragma unroll 1
    for (int l = 0; l < DEPTH; ++l) {
        {
            pg8::Gemm g{Xb, (const bf16_t*)(ws + OFF_WIN) + (size_t)l * NIN * DM, T_TOK, NIN, DM, 0, 0};
            pg8::StaticOrder S; S.init(T_TOK, NIN, G, bid);
            EpiZ E{Z, ssq + l * T_TOK, (const float*)(ws + OFF_LBS) + l * WM};
            pg8::gemm_phase(lds, g, S, E);
        }
        GSYNC();
        {
            {
                const int bn0 = bid & 31, n0 = bn0 & 15;
                const RgSetup st = rg_setup((const bf16_t*)(ws + OFF_RGW) + (size_t)(l * 16 + n0) * 8192, a.in[13] + l * 4 * WM, a.in[14] + l * WM,
                                            a.in[16] + l * WM, a.in[18] + l * WM, a.in[19] + l * WM, n0);
#pragma unroll 1
                for (int j = 0; j < 3; ++j) {
                    int it;
                    if (bid < 128) { if (j > 0) break; it = bid; } else it = 128 + (bid - 128) + 128 * j;
                    const int seg = it >> 5, bn = it & 31, b = bn >> 4, n = bn & 15;
                    rg_item(lds, Z, Y3 + (size_t)T_TOK * WM, st, seg, b, n, (float*)(ws + OFF_RGS), (unsigned*)(ws + OFF_FLG), (unsigned)(l + 1));
                }
            }
            if (bid < 128) {
                const int b = bid >> 6, g = bid & 63;
                s5_item(lds, Z, Ypre, (const float2*)(ws + OFF_S5A) + (l * 64 + g) * 64, (const bf16_t*)(ws + OFF_S5BT) + (size_t)(l * 64 + g) * 2048,
                        (const bf16_t*)(ws + OFF_S5CT) + (size_t)(l * 64 + g) * 2048, a.in[10] + l * WM, b, g);
                {
                    pg8::Gemm g2{Ypre, (const bf16_t*)(ws + OFF_WGLU) + (size_t)l * WM * WM, T_TOK, WM, WM, 0, 0};
                    pg8::StaticOrder S; S.init(T_TOK, WM, 128, bid);
                    pg8::Unit u0; S.next(0, u0);
                    unsigned* s5cnt = (unsigned*)(ws + OFF_FLG) + 2048;
                    asm volatile("s_waitcnt vmcnt(0)" ::: "memory");
                    __syncthreads();
                    if (threadIdx.x == 0) {
                        __builtin_amdgcn_fence(__ATOMIC_RELEASE, "agent");
                        asm volatile("s_waitcnt vmcnt(0)" ::: "memory");
                        __hip_atomic_fetch_add(s5cnt + 64 * b, 1u, __ATOMIC_RELAXED, __HIP_MEMORY_SCOPE_AGENT);
                        unsigned spins = 0;
                        while (__hip_atomic_load(s5cnt + 64 * (u0.pm >> 4), __ATOMIC_RELAXED, __HIP_MEMORY_SCOPE_AGENT) < 64u * (unsigned)(l + 1)) {
                            __builtin_amdgcn_s_sleep(2); if (++spins > (1u << 22)) break; }
                        __builtin_amdgcn_fence(__ATOMIC_ACQUIRE, "agent");
                        asm volatile("s_waitcnt vmcnt(0)" ::: "memory");
                    }
                    __syncthreads();
                    EpiGlu E{Ypre, Z, a.in[12] + l * WM, Y3};
                    pg8::gemm_phase(lds, g2, S, E);
                }
            } else {
                const int i = bid - 128, seg = i >> 4, bh = i & 15;
                hg_item(lds, Z, Y3 + (size_t)2 * T_TOK * WM, a.in[21] + l * WM, bh >> 3, bh & 7, seg, (float*)(ws + OFF_OL), (bf16_t*)(ws + OFF_QH),
                        (float*)(ws + OFF_USEG), (float*)(ws + OFF_DSEG), (unsigned*)(ws + OFF_FLG) + 1024, (unsigned)(l + 1));
            }
        }
        GSYNC();
        {
            pg8::Gemm g{Y3, (const bf16_t*)(ws + OFF_WBR) + (size_t)l * 3 * DM * WM, T_TOK, DM, WM, (size_t)T_TOK * WM * 2, (size_t)DM * WM * 2};
            pg8::Order3 S; S.init(T_TOK, DM, G, bid);
            EpiBr E{Z, Mrg};
            pg8::gemm_phase(lds, g, S, E);
        }
        GSYNC();
        {
            pg8::Gemm g{Mrg, (const bf16_t*)(ws + OFF_WOUT) + (size_t)l * DM * DM, T_TOK, DM, DM, 0, 0};
            pg8::StaticOrder S; S.init(T_TOK, DM, G, bid);
            EpiOut E{l == 0 ? a.in[0] : nullptr, Xb, ssq + (l + 1) * T_TOK};
            pg8::gemm_phase(lds, g, S, E);
        }
        GSYNC();
    }
    {
        const int tid = opaque_tid(), lane = tid & 63, wave = tid >> 6;
        const float* fw = a.in[24]; const u64* sq = ssq + 4 * T_TOK;
        for (int row = bid * 8 + wave; row < T_TOK; row += G * 8) {
            const float rs = ssq_rstd(sq + row);
#pragma unroll
            for (int j = 0; j < 8; ++j) {
                const int col = 4 * lane + 256 * j;
                const u32x2 xw = *(const u32x2*)(Xb + (size_t)row * DM + col); const f32x4 v = (f32x4){bflo(xw.x), bfhi(xw.x), bflo(xw.y), bfhi(xw.y)}; const f32x4 wv = *(const f32x4*)(fw + col);
                *(f32x4*)(a.out + (size_t)row * DM + col) = v * rs * wv;
            }
        }
    }
}

extern "C" void kernel_launch(void* const* d_in, const int* in_sizes, int n_in, void* d_out, int out_size, void* d_ws, size_t ws_size, hipStream_t stream) {
    static int grid = 0;
    if (grid == 0) {
        if (n_in != 25 || ws_size < WS_END) { fprintf(stderr, "kernel_launch: unexpected n_in %d or ws_size %zu (need %zu)\n", n_in, ws_size, (size_t)WS_END); grid = -1; return; }
        int dev = 0, cus = 0, per = 0;
        (void)hipGetDevice(&dev); (void)hipDeviceGetAttribute(&cus, hipDeviceAttributeMultiprocessorCount, dev);
        if (hipFuncSetAttribute((const void*)mk_fwd, hipFuncAttributeMaxDynamicSharedMemorySize, LDS_BYTES) != hipSuccess) fprintf(stderr, "kernel_launch: hipFuncSetAttribute failed\n");
        (void)hipOccupancyMaxActiveBlocksPerMultiprocessor(&per, (const void*)mk_fwd, 512, LDS_BYTES);
        (void)hipGetLastError();
        grid = cus > 0 ? cus : 256;
        if (grid > 256) grid = 256;
    }
    if (grid < 0) return;
    (void)hipMemsetAsync((unsigned char*)d_ws + OFF_BAR, 0, 32768, stream);
    Args a{};
    for (int i = 0; i < 25; ++i) a.in[i] = (const float*)d_in[i];
    a.out = (float*)d_out; a.ws = (unsigned char*)d_ws;
    void* args[] = {&a};
    hipError_t e = hipLaunchCooperativeKernel((void*)mk_fwd, dim3(grid), dim3(512), args, LDS_BYTES, stream);
    if (e != hipSuccess) fprintf(stderr, "cooperative launch failed: %s (grid %d)\n", hipGetErrorString(e), grid);
}
```
